# Optimizing an MI355X kernel written in HIP

```python
import math
import jax, jax.numpy as jnp
from jax import lax
import numpy as np

D_MODEL = 1024
BATCH = 4
SEQ = 8192
DEPTH = 2

HEAD_DIM = 64
GRID_W = 64
NA_HEADS = 8
NA_WIN_ROWS = 8
NA_WIN_COLS = 16
DIFF_HEADS = 4
DENSE_Q_BLOCK = 128
SWA_Q_HEADS = 16
SWA_KV_HEADS = 4
SWA_WINDOW = 128
SWA_BLOCK = 128
ROPE_THETA = 10000.0
N_EXPERTS = 256
TOP_K = 8
N_GROUPS = 8
TOPK_GROUPS = 4
EXPERT_FF = 256
SHARED_FF = 256
ROUTED_SCALE = 2.5
MOE_BLOCK = 128
LN_EPS = 1e-5
DN_ALPHA = (2 * DEPTH) ** 0.25
DN_BETA = (8 * DEPTH) ** -0.25
NA_WIDTH = NA_HEADS * HEAD_DIM
DIFF_QK_WIDTH = DIFF_HEADS * 2 * HEAD_DIM
DIFF_V_WIDTH = DIFF_HEADS * 2 * HEAD_DIM
EVEN_IN = 3 * NA_WIDTH + 2 * DIFF_QK_WIDTH + DIFF_V_WIDTH
SWA_Q_WIDTH = SWA_Q_HEADS * HEAD_DIM
SWA_KV_WIDTH = SWA_KV_HEADS * HEAD_DIM
ODD_IN = SWA_Q_WIDTH + 2 * SWA_KV_WIDTH

kernel_name = "hybrid_natten_diffattn_swa_moe_encoder"


def layer_norm(x, g, b):
    xf = x.astype(jnp.float32)
    mu = xf.mean(-1, keepdims=True)
    var = jnp.square(xf - mu).mean(-1, keepdims=True)
    y = (xf - mu) * lax.rsqrt(var + LN_EPS) * g.astype(jnp.float32) + b.astype(jnp.float32)
    return y.astype(x.dtype)


def rope_tables(seq_len):
    inv = 1.0 / (ROPE_THETA ** (jnp.arange(0, HEAD_DIM, 2, dtype=jnp.float32) / HEAD_DIM))
    ang = jnp.arange(seq_len, dtype=jnp.float32)[:, None] * inv[None, :]
    ang = jnp.concatenate([ang, ang], axis=-1)
    return jnp.cos(ang), jnp.sin(ang)


def apply_rope(t, cos, sin):
    tf = t.astype(jnp.float32)
    t1, t2 = jnp.split(tf, 2, axis=-1)
    rot = jnp.concatenate([-t2, t1], axis=-1)
    return (tf * cos[:, None, :] + rot * sin[:, None, :]).astype(t.dtype)


def neighbourhood_attention(q, k, v, rpb):
    b, s, h, d = q.shape
    rows_n = s // GRID_W
    kh = min(NA_WIN_ROWS, rows_n)
    kw = NA_WIN_COLS

    def grid(t):
        return t.reshape(b, rows_n, GRID_W, h, d).transpose(0, 3, 1, 2, 4)

    qg, kg, vg = grid(q), grid(k), grid(v)
    rows = jnp.arange(rows_n)
    row_start = jnp.clip(rows - kh // 2, 0, rows_n - kh)
    key_rows = row_start[:, None] + jnp.arange(kh)[None, :]
    k_nb = kg[:, :, key_rows]
    v_nb = vg[:, :, key_rows]
    cols = jnp.arange(GRID_W)
    col_start = jnp.clip(cols - kw // 2, 0, GRID_W - kw)
    col_off = cols[None, :] - col_start[:, None]
    col_valid = (col_off >= 0) & (col_off < kw)
    dr = key_rows - rows[:, None] + (NA_WIN_ROWS - 1)
    dc = jnp.clip(cols[None, :] - cols[:, None], -(kw - 1), kw - 1) + (kw - 1)
    bias = rpb[:, dr[:, None, :, None], dc[None, :, None, :]]
    scores = jnp.einsum('bhrqd,bhrikd->bhrqik', qg, k_nb).astype(jnp.float32) * (d ** -0.5)
    scores = scores + bias.astype(jnp.float32)[None]
    scores = jnp.where(col_valid[:, None, :], scores, -jnp.inf)
    p = jax.nn.softmax(scores.reshape(b, h, rows_n, GRID_W, kh * GRID_W), axis=-1)
    p = p.reshape(scores.shape).astype(v.dtype)
    o = jnp.einsum('bhrqik,bhrikd->bhrqd', p, v_nb)
    return o.transpose(0, 2, 3, 1, 4).reshape(b, s, h * d)


def differential_attention(q, k, v, lq1, lk1, lq2, lk2, subln_g, lambda_init, cos, sin):
    b, s, h, _, d = q.shape
    q = apply_rope(q.reshape(b, s, 2 * h, d), cos, sin).reshape(b, s, h, 2, d)
    k = apply_rope(k.reshape(b, s, 2 * h, d), cos, sin).reshape(b, s, h, 2, d)
    q1, q2 = q[:, :, :, 0].transpose(0, 2, 1, 3), q[:, :, :, 1].transpose(0, 2, 1, 3)
    k1, k2 = k[:, :, :, 0].transpose(0, 2, 1, 3), k[:, :, :, 1].transpose(0, 2, 1, 3)
    vt = v.transpose(0, 2, 1, 3)
    f32 = jnp.float32
    lam = (jnp.exp(jnp.sum(lq1.astype(f32) * lk1.astype(f32)))
           - jnp.exp(jnp.sum(lq2.astype(f32) * lk2.astype(f32))) + lambda_init)
    nb = s // DENSE_Q_BLOCK
    scale = d ** -0.5

    def to_blocks(t):
        return t.reshape(b, h, nb, DENSE_Q_BLOCK, d).transpose(2, 0, 1, 3, 4)

    def attend(qs):
        q1b, q2b = qs
        p1 = jax.nn.softmax(jnp.einsum('bhqd,bhkd->bhqk', q1b, k1).astype(f32) * scale, axis=-1)
        p2 = jax.nn.softmax(jnp.einsum('bhqd,bhkd->bhqk', q2b, k2).astype(f32) * scale, axis=-1)
        return jnp.einsum('bhqk,bhke->bhqe', (p1 - lam * p2).astype(v.dtype), vt)

    o = lax.map(attend, (to_blocks(q1), to_blocks(q2)))
    o = o.transpose(1, 0, 3, 2, 4).reshape(b, s, h, 2 * d).astype(f32)
    o = o * lax.rsqrt(jnp.mean(jnp.square(o), axis=-1, keepdims=True) + LN_EPS)
    o = o * subln_g.astype(f32) * (1.0 - lambda_init)
    return o.reshape(b, s, h * 2 * d).astype(v.dtype)


def sliding_window_gqa(q, k, v, sinks, cos, sin):
    b, s, hq, d = q.shape
    hkv = k.shape[2]
    g = hq // hkv
    q = apply_rope(q, cos, sin)
    k = apply_rope(k, cos, sin)
    nb = s // SWA_BLOCK
    qb = q.reshape(b, nb, SWA_BLOCK, hkv, g, d)

    def band(t):
        tp = jnp.pad(t, ((0, 0), (SWA_BLOCK, SWA_BLOCK), (0, 0), (0, 0)))
        tp = tp.reshape(b, nb + 2, SWA_BLOCK, hkv, d)
        return jnp.concatenate([tp[:, :nb], tp[:, 1:nb + 1], tp[:, 2:nb + 2]], axis=2)

    kb, vb = band(k), band(v)
    scores = jnp.einsum('bnqkgd,bnjkd->bnkgqj', qb, kb).astype(jnp.float32) * (d ** -0.5)
    blocks = jnp.arange(nb)[:, None]
    qpos = blocks * SWA_BLOCK + jnp.arange(SWA_BLOCK)[None, :]
    kpos = (blocks - 1) * SWA_BLOCK + jnp.arange(3 * SWA_BLOCK)[None, :]
    valid = ((jnp.abs(kpos[:, None, :] - qpos[:, :, None]) <= SWA_WINDOW)
             & (kpos >= 0)[:, None, :] & (kpos < s)[:, None, :])
    scores = jnp.where(valid[None, :, None, None], scores, -jnp.inf)
    sink = sinks.astype(jnp.float32).reshape(hkv, g)[None, None, :, :, None]
    m = jnp.maximum(scores.max(axis=-1), sink)
    e = jnp.exp(scores - m[..., None])
    denom = e.sum(axis=-1) + jnp.exp(sink - m)
    p = (e / denom[..., None]).astype(v.dtype)
    o = jnp.einsum('bnkgqj,bnjkd->bnqkgd', p, vb)
    return o.reshape(b, s, hq * d)


def even_mixer(x, w_in, w_out, rpb, lq1, lk1, lq2, lk2, subln_g, lambda_init, cos, sin):
    b, s, _ = x.shape
    hcat = x @ w_in
    cuts = np.cumsum([NA_WIDTH, NA_WIDTH, NA_WIDTH, DIFF_QK_WIDTH, DIFF_QK_WIDTH]).tolist()
    qa, ka, va, qd, kd, vd = jnp.split(hcat, cuts, axis=-1)
    shp = (b, s, NA_HEADS, HEAD_DIM)
    oa = neighbourhood_attention(qa.reshape(shp), ka.reshape(shp), va.reshape(shp), rpb)
    od = differential_attention(
        qd.reshape(b, s, DIFF_HEADS, 2, HEAD_DIM), kd.reshape(b, s, DIFF_HEADS, 2, HEAD_DIM),
        vd.reshape(b, s, DIFF_HEADS, 2 * HEAD_DIM), lq1, lk1, lq2, lk2, subln_g, lambda_init, cos, sin)
    return jnp.concatenate([oa, od], axis=-1) @ w_out


def odd_mixer(x, w_in, w_out, sinks, cos, sin):
    b, s, _ = x.shape
    hcat = x @ w_in
    q, k, v = jnp.split(hcat, [SWA_Q_WIDTH, SWA_Q_WIDTH + SWA_KV_WIDTH], axis=-1)
    o = sliding_window_gqa(q.reshape(b, s, SWA_Q_HEADS, HEAD_DIM),
                           k.reshape(b, s, SWA_KV_HEADS, HEAD_DIM),
                           v.reshape(b, s, SWA_KV_HEADS, HEAD_DIM), sinks, cos, sin)
    return o @ w_out


def moe_ffn(x, router_w, router_bias, w_gate, w_up, w_down, sh_gate, sh_up, sh_down):
    b, s, d = x.shape
    t = b * s
    xf = x.reshape(t, d)
    scores = jax.nn.sigmoid((xf @ router_w).astype(jnp.float32))
    choice = scores + router_bias.astype(jnp.float32)
    grp = choice.reshape(t, N_GROUPS, N_EXPERTS // N_GROUPS)
    grp_score = lax.top_k(grp, 2)[0].sum(axis=-1)
    _, grp_idx = lax.top_k(grp_score, TOPK_GROUPS)
    grp_mask = jnp.any(grp_idx[:, :, None] == jnp.arange(N_GROUPS)[None, None, :], axis=1)
    exp_mask = jnp.repeat(grp_mask, N_EXPERTS // N_GROUPS, axis=1)
    _, top_idx = lax.top_k(jnp.where(exp_mask, choice, -jnp.inf), TOP_K)
    gates = jnp.take_along_axis(scores, top_idx, axis=1)
    gates = gates / gates.sum(axis=-1, keepdims=True) * ROUTED_SCALE
    n_assign = t * TOP_K
    flat_e = top_idx.reshape(n_assign)
    flat_tok = jnp.repeat(jnp.arange(t, dtype=jnp.int32), TOP_K)
    flat_g = gates.reshape(n_assign)
    order = jnp.argsort(flat_e)
    e_s, tok_s, g_s = flat_e[order], flat_tok[order], flat_g[order]
    counts = jnp.bincount(flat_e, length=N_EXPERTS)
    padded = (counts + MOE_BLOCK - 1) // MOE_BLOCK * MOE_BLOCK
    pad_end = jnp.cumsum(padded)
    pad_start = pad_end - padded
    sort_start = jnp.cumsum(counts) - counts
    slot = pad_start[e_s] + jnp.arange(n_assign) - sort_start[e_s]
    n_blocks = -(-n_assign // MOE_BLOCK) + N_EXPERTS
    n_slots = n_blocks * MOE_BLOCK
    tok_buf = jnp.zeros((n_slots,), jnp.int32).at[slot].set(tok_s)
    gate_buf = jnp.zeros((n_slots,), x.dtype).at[slot].set(g_s.astype(x.dtype))
    blk_expert = jnp.minimum(
        jnp.searchsorted(pad_end, jnp.arange(n_blocks) * MOE_BLOCK, side='right'), N_EXPERTS - 1)

    def expert_block(args):
        tok_b, g_b, e = args
        xb = xf[tok_b]
        hb = jax.nn.silu(xb @ w_gate[e]) * (xb @ w_up[e])
        return (hb @ w_down[e]) * g_b[:, None]

    ys = lax.map(expert_block, (tok_buf.reshape(n_blocks, MOE_BLOCK),
                                gate_buf.reshape(n_blocks, MOE_BLOCK), blk_expert))
    routed = jax.ops.segment_sum(ys.reshape(n_slots, d), tok_buf, num_segments=t)
    shared = (jax.nn.silu(xf @ sh_gate) * (xf @ sh_up)) @ sh_down
    return (routed + shared).reshape(b, s, d)


def setup_inputs(seed: int = 0) -> dict:
    key = jax.random.key(seed)
    ks = iter(jax.random.split(key, 64))

    def nrm(shape, scale):
        return jax.random.normal(next(ks), shape, jnp.float32) * scale

    def gain(n):
        return 1.0 + nrm((n,), 0.02)

    def moe_params(prefix):
        return {
            prefix + 'router_w': nrm((D_MODEL, N_EXPERTS), D_MODEL ** -0.5),
            prefix + 'router_bias': nrm((N_EXPERTS,), 0.01),
            prefix + 'expert_w_gate': nrm((N_EXPERTS, D_MODEL, EXPERT_FF), D_MODEL ** -0.5),
            prefix + 'expert_w_up': nrm((N_EXPERTS, D_MODEL, EXPERT_FF), D_MODEL ** -0.5),
            prefix + 'expert_w_down': nrm((N_EXPERTS, EXPERT_FF, D_MODEL), EXPERT_FF ** -0.5 * DN_BETA),
            prefix + 'shared_w_gate': nrm((D_MODEL, SHARED_FF), D_MODEL ** -0.5),
            prefix + 'shared_w_up': nrm((D_MODEL, SHARED_FF), D_MODEL ** -0.5),
            prefix + 'shared_w_down': nrm((SHARED_FF, D_MODEL), SHARED_FF ** -0.5 * DN_BETA),
        }

    x = nrm((BATCH, SEQ, D_MODEL), 1.0)
    even_col_scale = jnp.concatenate([
        jnp.ones((2 * NA_WIDTH,), jnp.float32), jnp.full((NA_WIDTH,), DN_BETA, jnp.float32),
        jnp.ones((2 * DIFF_QK_WIDTH,), jnp.float32), jnp.full((DIFF_V_WIDTH,), DN_BETA, jnp.float32)])
    odd_col_scale = jnp.concatenate([
        jnp.ones((SWA_Q_WIDTH + SWA_KV_WIDTH,), jnp.float32),
        jnp.full((SWA_KV_WIDTH,), DN_BETA, jnp.float32)])
    l0 = {
        'l0_w_in': nrm((D_MODEL, EVEN_IN), D_MODEL ** -0.5) * even_col_scale,
        'l0_w_out': nrm((NA_WIDTH + DIFF_V_WIDTH, D_MODEL), (NA_WIDTH + DIFF_V_WIDTH) ** -0.5 * DN_BETA),
        'l0_na_rpb': nrm((NA_HEADS, 2 * NA_WIN_ROWS - 1, 2 * NA_WIN_COLS - 1), 0.02),
        'l0_diff_lq1': nrm((HEAD_DIM,), 0.1),
        'l0_diff_lk1': nrm((HEAD_DIM,), 0.1),
        'l0_diff_lq2': nrm((HEAD_DIM,), 0.1),
        'l0_diff_lk2': nrm((HEAD_DIM,), 0.1),
        'l0_diff_subln_g': gain(2 * HEAD_DIM),
        'l0_ln1_g': gain(D_MODEL),
        'l0_ln1_b': nrm((D_MODEL,), 0.02),
    }
    l0.update(moe_params('l0_'))
    l0.update({'l0_ln2_g': gain(D_MODEL), 'l0_ln2_b': nrm((D_MODEL,), 0.02)})
    l1 = {
        'l1_w_in': nrm((D_MODEL, ODD_IN), D_MODEL ** -0.5) * odd_col_scale,
        'l1_w_out': nrm((SWA_Q_WIDTH, D_MODEL), SWA_Q_WIDTH ** -0.5 * DN_BETA),
        'l1_swa_sinks': nrm((SWA_Q_HEADS,), 0.5),
        'l1_ln1_g': gain(D_MODEL),
        'l1_ln1_b': nrm((D_MODEL,), 0.02),
    }
    l1.update(moe_params('l1_'))
    l1.update({'l1_ln2_g': gain(D_MODEL), 'l1_ln2_b': nrm((D_MODEL,), 0.02)})
    out = {'x': x}
    out.update(l0)
    out.update(l1)
    return out


def reference(x,
              l0_w_in, l0_w_out, l0_na_rpb, l0_diff_lq1, l0_diff_lk1, l0_diff_lq2, l0_diff_lk2,
              l0_diff_subln_g, l0_ln1_g, l0_ln1_b,
              l0_router_w, l0_router_bias, l0_expert_w_gate, l0_expert_w_up, l0_expert_w_down,
              l0_shared_w_gate, l0_shared_w_up, l0_shared_w_down, l0_ln2_g, l0_ln2_b,
              l1_w_in, l1_w_out, l1_swa_sinks, l1_ln1_g, l1_ln1_b,
              l1_router_w, l1_router_bias, l1_expert_w_gate, l1_expert_w_up, l1_expert_w_down,
              l1_shared_w_gate, l1_shared_w_up, l1_shared_w_down, l1_ln2_g, l1_ln2_b):
    seq_len = x.shape[1]
    cos, sin = rope_tables(seq_len)

    def mixer0(h, l):
        lambda_init = 0.8 - 0.6 * math.exp(-0.3 * l)
        return even_mixer(h, l0_w_in, l0_w_out, l0_na_rpb, l0_diff_lq1, l0_diff_lk1,
                          l0_diff_lq2, l0_diff_lk2, l0_diff_subln_g, lambda_init, cos, sin)

    def mixer1(h, l):
        return odd_mixer(h, l1_w_in, l1_w_out, l1_swa_sinks, cos, sin)

    mixers = (mixer0, mixer1)
    moes = ((l0_router_w, l0_router_bias, l0_expert_w_gate, l0_expert_w_up, l0_expert_w_down,
             l0_shared_w_gate, l0_shared_w_up, l0_shared_w_down),
            (l1_router_w, l1_router_bias, l1_expert_w_gate, l1_expert_w_up, l1_expert_w_down,
             l1_shared_w_gate, l1_shared_w_up, l1_shared_w_down))
    norms = ((l0_ln1_g, l0_ln1_b, l0_ln2_g, l0_ln2_b),
             (l1_ln1_g, l1_ln1_b, l1_ln2_g, l1_ln2_b))
    for l in range(DEPTH):
        g1, b1, g2, b2 = norms[l]
        x = layer_norm(DN_ALPHA * x + mixers[l](x, l), g1, b1)
        x = layer_norm(DN_ALPHA * x + moe_ffn(x, *moes[l]), g2, b2)
    return x
```

```cpp
#include <hip/hip_runtime.h>
#include <cstdio>
#include <cstdint>
#define MK_N_LAUNCHES 1
namespace pg8 {
#define PG8_LAS __attribute__((address_space(3)))
typedef unsigned short bf16_t;
typedef short bf16x8 __attribute__((ext_vector_type(8)));
typedef float f32x4 __attribute__((ext_vector_type(4)));
typedef unsigned u32x4 __attribute__((ext_vector_type(4)));
constexpr int BM = 256, BK = 64, HALF = 128, HTB = HALF * BK * 2, STAGE_BYTES = 8 * HTB, NXCD = 8, WGM = 8;

__host__ __device__ __forceinline__ int lds_byte(int r, int c) { const int st = (r >> 4) * 2 + (c >> 5), rr = r & 15, cc = c & 31, ob = rr * 64 + cc * 2; return st * 1024 + (ob ^ (((ob >> 9) & 1) << 5)); }
__host__ __device__ __forceinline__ void stage_rc(int b, int& R, int& C) { const int st = b / 1024, sb = b % 1024, swz = sb ^ (((sb >> 9) & 1) << 5); R = (st >> 1) * 16 + swz / 64; C = (st & 1) * 32 + (swz % 64) / 2; }
__host__ __device__ __forceinline__ int perm32(int rho) { const int n = rho >> 4, i = rho & 15; return 8 * (i >> 2) + 4 * n + (i & 3); }

struct Unit { int pm, pn, e; const char* A; const char* B; };

__device__ __forceinline__ unsigned cvt_pk_bf16(float lo, float hi) { unsigned r; asm volatile("v_cvt_pk_bf16_f32 %0, %1, %2" : "=v"(r) : "v"(lo), "v"(hi)); return r; }

struct DenseOrder {
    static constexpr bool GATHER = false;
    int nM, nN, nwg, G, c, K; const char* A; const char* B;
    __device__ void init(const void* A_, const void* B_, int M, int N, int K_, int G_, int c_) { A = (const char*)A_; B = (const char*)B_; K = K_; nM = M / BM; nN = N / BM; nwg = nM * nN; G = G_; c = c_; }
    __device__ __forceinline__ bool next(int i, Unit& u) const {
        const long L = (long)i * G + c; if (L >= nwg) return false;
        int wgid = (int)L; { const int q = nwg / NXCD, r = nwg % NXCD, xcd = wgid % NXCD, off = wgid / NXCD; wgid = (xcd < r ? xcd * (q + 1) : r * (q + 1) + (xcd - r) * q) + off; }
        const int nig = WGM * nN, gid = wgid / nig, fm = gid * WGM, gsz = (nM - fm) < WGM ? (nM - fm) : WGM;
        u.pm = fm + ((wgid % nig) % gsz); u.pn = (wgid % nig) / gsz; u.e = 0;
        u.A = A + (size_t)u.pm * BM * K * 2; u.B = B + (size_t)u.pn * BM * K * 2; return true;
    }
    __device__ __forceinline__ int arow(const Unit&, int row) const { return row; }
};

template <class Epi, class Sched, bool ALIGN_EPI>
__device__ __forceinline__ void gemm_phase(PG8_LAS unsigned char* lds, const int K, const Sched& S, const Epi& E) {
    int tid_ = threadIdx.x; asm volatile("" : "+v"(tid_));
    const int tid = tid_, wid = __builtin_amdgcn_readfirstlane(tid >> 6), lane = tid & 63, wr = wid >> 2, wc = wid & 3, fr = lane & 15, fq = lane >> 4;
    const int nt = K / BK;
    int sR[2], sC[2];
    unsigned voffB[2];
#pragma unroll
    for (int i = 0; i < 2; ++i) { stage_rc(tid * 16 + i * 8192, sR[i], sC[i]); const int Rb = Epi::PERM ? ((sR[i] & ~31) + perm32(sR[i] & 31)) : sR[i]; voffB[i] = (unsigned)(Rb * K + sC[i]) * 2u; }
    const size_t kstep = (size_t)(BK * 2);
    const size_t hstepB = (size_t)HALF * K * 2;
    const unsigned ldsw = (unsigned)wid * 1024u;
    const int aoff = lds_byte(wr * 64 + fr, fq * 8), boff = lds_byte(wc * 32 + fr, fq * 8);
#define PG8_SA(b, h) (((b) * 2 + (h)) * HTB)
#define PG8_SB(b, h) ((4 + (b) * 2 + (h)) * HTB)
#define PG8_STAGE(bufoff, gbase, voff) do { _Pragma("unroll") for (int _i = 0; _i < 2; ++_i) \
        __builtin_amdgcn_global_load_lds((const unsigned*)((const char*)(gbase) + (voff)[_i]), (PG8_LAS unsigned*)(lds + (bufoff) + ldsw + _i * 8192), 16, 0, 0); } while (0)
#define PG8_LDA(dst, b, h) do { _Pragma("unroll") for (int m = 0; m < 4; ++m) _Pragma("unroll") for (int k = 0; k < 2; ++k) dst[m][k] = *(const PG8_LAS bf16x8*)(lds + PG8_SA(b, h) + aoff + m * 2048 + k * 1024); } while (0)
#define PG8_LDB(dst, b, h) do { _Pragma("unroll") for (int n = 0; n < 2; ++n) _Pragma("unroll") for (int k = 0; k < 2; ++k) dst[n][k] = *(const PG8_LAS bf16x8*)(lds + PG8_SB(b, h) + boff + n * 2048 + k * 1024); } while (0)
#define PG8_MMA(ai, bj, At, Bt) do { __builtin_amdgcn_s_setprio(1); _Pragma("unroll") for (int m = 0; m < 4; ++m) _Pragma("unroll") for (int n = 0; n < 2; ++n) _Pragma("unroll") for (int k = 0; k < 2; ++k) \
        acc[ai][bj][m][n] = __builtin_amdgcn_mfma_f32_16x16x32_bf16(Bt[n][k], At[m][k], acc[ai][bj][m][n], 0, 0, 0); __builtin_amdgcn_s_setprio(0); } while (0)
#define PG8_WAIT_V(n) asm volatile("s_waitcnt vmcnt(" #n ")" ::: "memory")
#define PG8_WAIT_L(n) asm volatile("s_waitcnt lgkmcnt(" #n ")" ::: "memory")
#define PG8_BAR __builtin_amdgcn_s_barrier()
#define PG8_SCHED __builtin_amdgcn_sched_barrier(0)
#define PG8_VOFFA(dst, u) do { _Pragma("unroll") for (int _h = 0; _h < 2; ++_h) _Pragma("unroll") for (int _i = 0; _i < 2; ++_i) { \
        const int _row = 128 * _h + sR[_i]; const unsigned _rg = Sched::GATHER ? (unsigned)S.arow(u, _row) : (unsigned)_row; \
        dst[_h][_i] = (_rg * (unsigned)K + (unsigned)sC[_i]) * 2u; } } while (0)
    Unit cur, nxt; int ui = 0;
    if (!S.next(0, cur)) return;
    f32x4 acc[2][2][4][2];
#pragma unroll
    for (int a = 0; a < 2; ++a)
#pragma unroll
        for (int b = 0; b < 2; ++b)
#pragma unroll
            for (int m = 0; m < 4; ++m)
#pragma unroll
                for (int n = 0; n < 2; ++n) acc[a][b][m][n] = (f32x4){0.f, 0.f, 0.f, 0.f};
    bf16x8 At[4][2], B0[2][2], B1[2][2];
    unsigned vo[2][2], nvo[2][2];
    PG8_VOFFA(vo, cur);
    const char* cA = cur.A; const char* cB = cur.B;
    PG8_STAGE(PG8_SB(0, 0), cB, voffB); PG8_STAGE(PG8_SB(0, 1), cB + hstepB, voffB); PG8_STAGE(PG8_SA(0, 0), cA, vo[0]); PG8_STAGE(PG8_SA(0, 1), cA, vo[1]);
    if (wr == 1) PG8_BAR;
    PG8_WAIT_V(2); PG8_BAR;
    PG8_STAGE(PG8_SB(1, 0), cB + kstep, voffB); PG8_STAGE(PG8_SA(1, 0), cA + kstep, vo[0]); PG8_STAGE(PG8_SB(1, 1), cB + hstepB + kstep, voffB);
    PG8_WAIT_V(6); PG8_BAR;
    for (;;) {
        const bool has_next = S.next(ui + 1, nxt);
        const char* nA = has_next ? nxt.A : cA; const char* nB = has_next ? nxt.B : cB;
        if constexpr (Sched::GATHER) { if (has_next) { PG8_VOFFA(nvo, nxt); } else {
#pragma unroll
            for (int h = 0; h < 2; ++h)
#pragma unroll
                for (int i = 0; i < 2; ++i) nvo[h][i] = vo[h][i]; } }
#pragma unroll 1
        for (int t = 0; t < nt; t += 2) {
            const bool last = (t == nt - 2);
            const char* a1 = cA + (size_t)(t + 1) * kstep;
            const char* a2 = last ? nA : cA + (size_t)(t + 2) * kstep; const char* b2 = last ? nB : cB + (size_t)(t + 2) * kstep;
            const char* a3 = a2 + kstep; const char* b3 = b2 + kstep;
            unsigned va2[2][2];
#pragma unroll
            for (int h = 0; h < 2; ++h)
#pragma unroll
                for (int i = 0; i < 2; ++i) va2[h][i] = (Sched::GATHER && last) ? nvo[h][i] : vo[h][i];
            PG8_LDB(B0, 0, 0); PG8_LDB(B1, 0, 1); PG8_SCHED; PG8_LDA(At, 0, 0); PG8_STAGE(PG8_SA(1, 1), a1, vo[1]);
            PG8_WAIT_V(8); PG8_WAIT_L(0); PG8_BAR; PG8_MMA(0, 0, At, B0); PG8_MMA(0, 1, At, B1); PG8_BAR; PG8_SCHED;
            PG8_LDA(At, 0, 1); PG8_STAGE(PG8_SB(0, 0), b2, voffB); PG8_STAGE(PG8_SB(0, 1), b2 + hstepB, voffB); PG8_STAGE(PG8_SA(0, 0), a2, va2[0]);
            PG8_WAIT_V(8); PG8_WAIT_L(0); PG8_BAR; PG8_MMA(1, 0, At, B0); PG8_MMA(1, 1, At, B1); PG8_BAR; PG8_SCHED;
            PG8_LDB(B0, 1, 0); PG8_LDB(B1, 1, 1); PG8_SCHED; PG8_LDA(At, 1, 0); PG8_STAGE(PG8_SA(0, 1), a2, va2[1]);
            PG8_WAIT_V(8); PG8_WAIT_L(0); PG8_BAR; PG8_MMA(0, 0, At, B0); PG8_MMA(0, 1, At, B1); PG8_BAR; PG8_SCHED;
            PG8_LDA(At, 1, 1); PG8_STAGE(PG8_SB(1, 0), b3, voffB); PG8_STAGE(PG8_SB(1, 1), b3 + hstepB, voffB); PG8_STAGE(PG8_SA(1, 0), a3, va2[0]);
            PG8_WAIT_V(8); PG8_WAIT_L(0); PG8_BAR; PG8_MMA(1, 0, At, B0); PG8_MMA(1, 1, At, B1); PG8_BAR; PG8_SCHED;
        }
        if constexpr (ALIGN_EPI) { if (wr == 0) PG8_BAR; }
        E(acc, cur, wr, wc, fr, fq);
        if (!has_next) break;
#pragma unroll
        for (int a = 0; a < 2; ++a)
#pragma unroll
            for (int b = 0; b < 2; ++b)
#pragma unroll
                for (int m = 0; m < 4; ++m)
#pragma unroll
                    for (int n = 0; n < 2; ++n) acc[a][b][m][n] = (f32x4){0.f, 0.f, 0.f, 0.f};
        cur = nxt; cA = nA; cB = nB; ++ui;
        if constexpr (Sched::GATHER) {
#pragma unroll
        for (int h = 0; h < 2; ++h)
#pragma unroll
            for (int i = 0; i < 2; ++i) vo[h][i] = nvo[h][i]; }
        if constexpr (ALIGN_EPI) { if (wr == 1) PG8_BAR; }
    }
    PG8_WAIT_V(0);
    if constexpr (!ALIGN_EPI) { if (wr == 0) PG8_BAR; }
    PG8_BAR;
#undef PG8_SA
#undef PG8_SB
#undef PG8_STAGE
#undef PG8_LDA
#undef PG8_LDB
#undef PG8_MMA
#undef PG8_WAIT_V
#undef PG8_WAIT_L
#undef PG8_BAR
#undef PG8_SCHED
#undef PG8_VOFFA
}
}
namespace att {
typedef unsigned short bf16_t;
using bf16x8 = __attribute__((ext_vector_type(8))) short;
using s16x4  = __attribute__((ext_vector_type(4))) short;
using f32x16 = __attribute__((ext_vector_type(16))) float;
using f32x4  = __attribute__((ext_vector_type(4))) float;
using u32x4  = __attribute__((ext_vector_type(4))) unsigned;
constexpr int NW = 8, QBLK = 32, KVBLK = 64;
constexpr float NEGV = -1e30f, MINIT = -1e29f, THR = 8.f;
#define ASBAR() __builtin_amdgcn_sched_barrier(0)
__device__ __forceinline__ int crow(int r, int hi) { return (r & 3) + 8 * (r >> 2) + 4 * hi; }
__device__ __forceinline__ unsigned cvtpk(float lo, float hi) { unsigned r; asm volatile("v_cvt_pk_bf16_f32 %0, %1, %2" : "=v"(r) : "v"(lo), "v"(hi)); return r; }
__device__ __forceinline__ int kswz(int row, int c8) { return row * 128 + ((c8 ^ ((row >> 1) & 7)) << 4); }
template <int NCB> __device__ __forceinline__ int v_st(int k, int c) { const int kk = (k & ~0xC) | ((k & 4) << 1) | ((k & 8) >> 1); return ((kk >> 3) * NCB + (c >> 5)) * 512 + ((kk & 7) * 32 + (c & 31)) * 2; }
__device__ __forceinline__ int v_rd_base(int lane) { return ((lane & 3) << 3) | (((lane >> 2) & 3) << 6) | (((lane >> 4) & 1) << 5) | (((lane >> 5) & 1) << 8); }
template <int OFF> __device__ __forceinline__ s16x4 tr_read(int vb) { s16x4 r; asm volatile("ds_read_b64_tr_b16 %0, %1 offset:%2" : "=&v"(r) : "v"(vb), "i"(OFF) : "memory"); return r; }

__device__ __forceinline__ void partialSM(f32x16& p0, f32x16& p1, float& m_reg, float& alpha) {
  float pmax = p0[0];
#pragma unroll
  for (int r = 1; r < 16; ++r) pmax = fmaxf(pmax, p0[r]);
#pragma unroll
  for (int r = 0; r < 16; ++r) pmax = fmaxf(pmax, p1[r]);
  { auto rr = __builtin_amdgcn_permlane32_swap(__float_as_uint(pmax), __float_as_uint(pmax), false, false);
    pmax = fmaxf(__uint_as_float(rr[0]), __uint_as_float(rr[1])); }
  float mn;
  if (__builtin_expect(__all(pmax - m_reg <= THR), 1)) { mn = m_reg; alpha = 1.f; }
  else { mn = fmaxf(m_reg, pmax); alpha = __builtin_amdgcn_exp2f(m_reg - mn); m_reg = mn; }
#pragma unroll
  for (int r = 0; r < 16; ++r) p0[r] = p0[r] - mn;
#pragma unroll
  for (int r = 0; r < 16; ++r) p1[r] = p1[r] - mn;
#pragma unroll
  for (int r = 0; r < 16; ++r) p0[r] = __builtin_amdgcn_exp2f(p0[r]);
}
__device__ __forceinline__ void finishSM(f32x16& p0, f32x16& p1, float alpha, float& l_reg, bf16x8& pa0, bf16x8& pa1, bf16x8& pa2, bf16x8& pa3) {
#pragma unroll
  for (int r = 0; r < 16; ++r) p1[r] = __builtin_amdgcn_exp2f(p1[r]);
  float ps = 0;
#pragma unroll
  for (int r = 0; r < 16; ++r) ps += p0[r];
#pragma unroll
  for (int r = 0; r < 16; ++r) ps += p1[r];
  { auto rr = __builtin_amdgcn_permlane32_swap(__float_as_uint(ps), __float_as_uint(ps), false, false);
    ps = __uint_as_float(rr[0]) + __uint_as_float(rr[1]); }
  l_reg = l_reg * alpha + ps;
#define PK4(P, BASE, OUT) do { unsigned a0 = cvtpk(P[BASE + 0], P[BASE + 1]), a1 = cvtpk(P[BASE + 2], P[BASE + 3]);   \
    unsigned b0 = cvtpk(P[BASE + 4], P[BASE + 5]), b1 = cvtpk(P[BASE + 6], P[BASE + 7]);                              \
    auto r0 = __builtin_amdgcn_permlane32_swap(a0, b0, false, false); auto r1 = __builtin_amdgcn_permlane32_swap(a1, b1, false, false); \
    u32x4 w = {r0[0], r1[0], r0[1], r1[1]}; OUT = *reinterpret_cast<bf16x8*>(&w); } while (0)
  PK4(p0, 0, pa0); PK4(p0, 8, pa1); PK4(p1, 0, pa2); PK4(p1, 8, pa3);
#undef PK4
}
template <bool QL>
__device__ __forceinline__ void qkt(f32x16& p0, f32x16& p1, const char* Ks, const bf16x8* qr, int qa, int r32, int hi) {
  p0 = f32x16{}; p1 = f32x16{};
  bf16x8 q0, q1, q2, q3;
  if constexpr (QL) { asm volatile("ds_read_b128 %0, %4\n\tds_read_b128 %1, %4 offset:1024\n\tds_read_b128 %2, %4 offset:2048\n\tds_read_b128 %3, %4 offset:3072\n\ts_waitcnt lgkmcnt(0)"
                                   : "=&v"(q0), "=&v"(q1), "=&v"(q2), "=&v"(q3) : "v"(qa) : "memory"); }
  else { q0 = qr[0]; q1 = qr[1]; q2 = qr[2]; q3 = qr[3]; }
#define QSTEP(d0, Q) do { const int c8 = (d0) * 2 + hi; \
    bf16x8 b0 = *reinterpret_cast<const bf16x8*>(Ks + kswz(r32, c8)); \
    bf16x8 b1 = *reinterpret_cast<const bf16x8*>(Ks + kswz(32 + r32, c8)); \
    p0 = __builtin_amdgcn_mfma_f32_32x32x16_bf16(b0, Q, p0, 0, 0, 0); \
    p1 = __builtin_amdgcn_mfma_f32_32x32x16_bf16(b1, Q, p1, 0, 0, 0); } while (0)
  QSTEP(0, q0); QSTEP(1, q1); QSTEP(2, q2); QSTEP(3, q3);
#undef QSTEP
}
template <int NCB, int D0> __device__ __forceinline__ void pv_one(f32x16& od, int vb, bf16x8 pa0, bf16x8 pa1, bf16x8 pa2, bf16x8 pa3) {
#define VRO(ks, half) (D0 * 512 + (ks) * (NCB * 1024) + (half) * (NCB * 512))
  const s16x4 l0 = tr_read<VRO(0, 0)>(vb), h0 = tr_read<VRO(0, 1)>(vb), l1 = tr_read<VRO(1, 0)>(vb), h1 = tr_read<VRO(1, 1)>(vb);
  const s16x4 l2 = tr_read<VRO(2, 0)>(vb), h2 = tr_read<VRO(2, 1)>(vb), l3 = tr_read<VRO(3, 0)>(vb), h3 = tr_read<VRO(3, 1)>(vb);
#undef VRO
  asm volatile("s_waitcnt lgkmcnt(0)" ::: "memory"); ASBAR();
#define PK(L, H) (bf16x8){L[0], L[1], L[2], L[3], H[0], H[1], H[2], H[3]}
  od = __builtin_amdgcn_mfma_f32_32x32x16_bf16(pa0, PK(l0, h0), od, 0, 0, 0);
  od = __builtin_amdgcn_mfma_f32_32x32x16_bf16(pa1, PK(l1, h1), od, 0, 0, 0);
  od = __builtin_amdgcn_mfma_f32_32x32x16_bf16(pa2, PK(l2, h2), od, 0, 0, 0);
  od = __builtin_amdgcn_mfma_f32_32x32x16_bf16(pa3, PK(l3, h3), od, 0, 0, 0);
#undef PK
}
template <int NCB> __device__ __forceinline__ void pv_all(f32x16 (&o)[NCB], int vb, bf16x8 pa0, bf16x8 pa1, bf16x8 pa2, bf16x8 pa3) {
  pv_one<NCB, 0>(o[0], vb, pa0, pa1, pa2, pa3); pv_one<NCB, 1>(o[1], vb, pa0, pa1, pa2, pa3);
  if constexpr (NCB == 4) { pv_one<NCB, 2>(o[2], vb, pa0, pa1, pa2, pa3); pv_one<NCB, 3>(o[3], vb, pa0, pa1, pa2, pa3); }
}

constexpr int L_V = 0, L_K = 32768, L_WS = 49152, L_STG = 51200, L_BIAS = 116736, ATT_LDS = 118784;

template <int DV, class Msk, bool QL = false>
__device__ __forceinline__ void attn_tiles(f32x16 (&o)[DV / 32], float& m_reg, float& l_reg, const bf16x8 (&qr)[4],
                                           const bf16_t* __restrict__ Kh, const bf16_t* __restrict__ Vh, const int ld, const int NT, const Msk& msk, char* lds, const int tid, int qa = 0) {
  constexpr int NCB = DV / 32, SHM_V = KVBLK * DV * 2, SHM_K = KVBLK * 64 * 2;
  const int wid = tid >> 6, lane = tid & 63, r32 = lane & 31, hi = lane >> 5;
  char* V_lds = lds + L_V; char* K_lds = lds + L_K;
  float* ws = (float*)(lds + L_WS) + wid * 64; float* al_l = ws + 32;
  const int kk_r = tid >> 3, kk_c = tid & 7;
  const int kst = kswz(kk_r, kk_c);
  const int vr = (DV == 128) ? (tid >> 4) : (tid >> 3), vc = (DV == 128) ? ((tid & 15) * 8) : ((tid & 7) * 8);
  const int vst0 = v_st<NCB>(vr, vc), vst1 = v_st<NCB>(32 + vr, vc);
  const int vb0 = (int)(uintptr_t)V_lds + v_rd_base(lane);
  constexpr int SD = (DV == 128) ? 1 : 2;
  struct { bf16x8 vs0, vs1, ks0; } sr_[SD];
  const unsigned voff0 = (unsigned)(vr * ld + vc) * 2u, voff1 = (unsigned)((32 + vr) * ld + vc) * 2u, koff = (unsigned)(kk_r * ld + kk_c * 8) * 2u;
  const char* Kb = (const char*)Kh; const char* Vb = (const char*)Vh; const size_t tstep = (size_t)KVBLK * ld * 2;
#define SLOAD(i, t) do { const char* _kb = Kb + (size_t)(t) * tstep; const char* _vb = Vb + (size_t)(t) * tstep; \
    sr_[i].vs0 = *reinterpret_cast<const bf16x8*>(_vb + voff0); \
    if constexpr (DV == 128) sr_[i].vs1 = *reinterpret_cast<const bf16x8*>(_vb + voff1); \
    sr_[i].ks0 = *reinterpret_cast<const bf16x8*>(_kb + koff); } while (0)
#define SWRITE(b, i) do { *(bf16x8*)(V_lds + (b) * SHM_V + vst0) = sr_[i].vs0; \
    if constexpr (DV == 128) *(bf16x8*)(V_lds + (b) * SHM_V + vst1) = sr_[i].vs1; \
    *(bf16x8*)(K_lds + (b) * SHM_K + kst) = sr_[i].ks0; } while (0)
#define SWAIT() do { if constexpr (SD == 2) asm volatile("s_waitcnt vmcnt(2)" ::: "memory"); } while (0)
#define RESC(a) do { if (__any((a) < 1.f)) { if (hi == 0) al_l[r32] = (a); asm volatile("s_waitcnt lgkmcnt(0)" ::: "memory"); \
    _Pragma("unroll") for (int d = 0; d < NCB; ++d) _Pragma("unroll") for (int r = 0; r < 16; ++r) o[d][r] *= al_l[crow(r, hi)]; } } while (0)
  f32x16 pA0, pA1, pB0, pB1; float alA, alB; bf16x8 pa0, pa1, pa2, pa3;
  constexpr int SE = 0, SO = SD - 1;
  SLOAD(SE, 0); asm volatile("s_waitcnt vmcnt(0)" ::: "memory"); SWRITE(0, SE); __syncthreads();
  qkt<QL>(pA0, pA1, K_lds, qr, qa, r32, hi); msk(pA0, pA1, 0, r32, hi); partialSM(pA0, pA1, m_reg, alA);
  SLOAD(SO, 1); if constexpr (SD == 2) { if (2 < NT) SLOAD(SE, 2); }
  SWAIT(); SWRITE(1, SO); __syncthreads();
  for (int j = 1; j + 1 < NT; j += 2) {
    ASBAR(); qkt<QL>(pB0, pB1, K_lds + SHM_K, qr, qa, r32, hi); msk(pB0, pB1, j, r32, hi);
    finishSM(pA0, pA1, alA, l_reg, pa0, pa1, pa2, pa3); ASBAR();
    SLOAD(SO, j + SD); ASBAR();
    pv_all<NCB>(o, vb0, pa0, pa1, pa2, pa3); partialSM(pB0, pB1, m_reg, alB);
    __syncthreads(); SWAIT(); SWRITE(0, SE);
    RESC(alB); __syncthreads();
    ASBAR(); qkt<QL>(pA0, pA1, K_lds, qr, qa, r32, hi); msk(pA0, pA1, j + 1, r32, hi);
    finishSM(pB0, pB1, alB, l_reg, pa0, pa1, pa2, pa3); ASBAR();
    if (SD == 1 || j + 3 < NT) SLOAD(SE, j + 1 + SD); ASBAR();
    pv_all<NCB>(o, vb0 + SHM_V, pa0, pa1, pa2, pa3); partialSM(pA0, pA1, m_reg, alA);
    __syncthreads(); SWAIT(); SWRITE(1, SO);
    RESC(alA); __syncthreads();
  }
  ASBAR(); qkt<QL>(pB0, pB1, K_lds + SHM_K, qr, qa, r32, hi); msk(pB0, pB1, NT - 1, r32, hi);
  finishSM(pA0, pA1, alA, l_reg, pa0, pa1, pa2, pa3); ASBAR();
  pv_all<NCB>(o, vb0, pa0, pa1, pa2, pa3); partialSM(pB0, pB1, m_reg, alB);
  __syncthreads(); RESC(alB);
  finishSM(pB0, pB1, alB, l_reg, pa0, pa1, pa2, pa3); ASBAR();
  pv_all<NCB>(o, vb0 + SHM_V, pa0, pa1, pa2, pa3);
#undef SLOAD
#undef SWRITE
#undef SWAIT
#undef RESC
}

template <int NCB> __device__ __forceinline__ void normalize_rows(f32x16 (&o)[NCB], float l_reg, char* lds, const int tid) {
  const int wid = tid >> 6, lane = tid & 63, r32 = lane & 31, hi = lane >> 5;
  float* ws = (float*)(lds + L_WS) + wid * 64;
  if (hi == 0) ws[r32] = l_reg; asm volatile("s_waitcnt lgkmcnt(0)" ::: "memory");
#pragma unroll
  for (int r = 0; r < 16; ++r) { const float rl = __builtin_amdgcn_rcpf(ws[crow(r, hi)]);
#pragma unroll
    for (int d = 0; d < NCB; ++d) o[d][r] *= rl; }
  asm volatile("s_waitcnt lgkmcnt(0)" ::: "memory");
}
template <int DV> __device__ __forceinline__ void store_rows(const f32x16 (&o)[DV / 32], bf16_t* out, const long ld, char* lds, const int tid) {
  constexpr int NCB = DV / 32;
  const int wid = tid >> 6, lane = tid & 63, r32 = lane & 31, hi = lane >> 5;
  bf16_t* stg = (bf16_t*)(lds + L_STG) + wid * (32 * 128);
#pragma unroll
  for (int r = 0; r < 16; ++r) { const int orow = crow(r, hi);
#pragma unroll
    for (int d0 = 0; d0 < NCB; ++d0) { const unsigned u = __float_as_uint(o[d0][r]); stg[orow * DV + d0 * 32 + r32] = (bf16_t)((u + 0x7fffu + ((u >> 16) & 1u)) >> 16); } }
  asm volatile("s_waitcnt lgkmcnt(0)" ::: "memory");
  constexpr int CPR = DV / 8, RPI = 64 / CPR;
#pragma unroll
  for (int i = 0; i < 32 / RPI; ++i) { const int row = i * RPI + lane / CPR, ch = lane % CPR;
    const u32x4 v = *(const u32x4*)(stg + row * DV + ch * 8); *(u32x4*)(out + (long)row * ld + ch * 8) = v; }
  asm volatile("s_waitcnt lgkmcnt(0)" ::: "memory");
}
struct NoMask { __device__ __forceinline__ void operator()(f32x16&, f32x16&, int, int, int) const {} };
#undef ASBAR
}
#ifndef MK_N_LAUNCHES
#define MK_N_LAUNCHES 1
#endif
constexpr int NPH = 22;
constexpr int NWAVES = 8;
constexpr int BATCH = 4, SEQ = 8192, T = BATCH * SEQ, DM = 1024;
constexpr int NEXP = 256, TOPK = 8;
constexpr int NSLOT_MAX = 327424;
constexpr int NTILE_E = NSLOT_MAX / 256;
constexpr int HROWS = NSLOT_MAX + T;
constexpr float LN_EPS = 1e-5f;
constexpr float DN_ALPHA = 1.4142135623730951f;
constexpr float LOG2E = 1.4426950408889634f;
constexpr float C2 = 0.125f * 1.4426950408889634f;
constexpr float LAMBDA_INIT0 = 0.2f;

constexpr size_t MiB = 1u << 20;
constexpr size_t WS_CTL = 0, CTL_ZERO_BYTES = 1 * MiB;
constexpr size_t WS_ROPE = 1 * MiB;
constexpr size_t WS_SEL_E = 3 * MiB, WS_SEL_G = 4 * MiB, WS_SEL_POS = 5 * MiB;
constexpr size_t WS_GTOK = 6 * MiB, WS_DEST = 8 * MiB;
constexpr size_t WS_O1S = 10 * MiB;
constexpr size_t WS_W0IN = 42 * MiB, WS_W0OUT = 48 * MiB, WS_R0 = 50 * MiB, WS_W1IN = 51 * MiB, WS_W1OUT = 54 * MiB, WS_R1 = 56 * MiB;
constexpr size_t WS_EGU = 57 * MiB;
constexpr size_t WS_ED = 314 * MiB;
constexpr size_t WS_X1 = 443 * MiB;
constexpr size_t WS_X1B = 571 * MiB;
constexpr size_t WS_H = 635 * MiB;
constexpr size_t WS_R = 811 * MiB;
constexpr size_t WS_XB = WS_R, WS_HCAT = WS_R + 64 * MiB, WS_ATT = WS_R + 256 * MiB, WS_Y = WS_R + 320 * MiB, WS_YS = WS_R;
constexpr size_t WS_END = 1387 * MiB;
static_assert(WS_EGU + (size_t)257 * 512 * 1024 * 2 <= WS_ED && WS_ED + (size_t)257 * 1024 * 256 * 2 <= WS_X1, "ws map: experts");
static_assert(WS_H + (size_t)HROWS * 256 * 2 <= WS_R && WS_YS + (size_t)(T * 9) * 1024 * 2 <= WS_END, "ws map: H / YS");
constexpr int CW_TMO = 0, CW_BAR = 4096, CW_CNT = 8192;

constexpr int RING_OFF = 0, RING_BYTES = 131072;
constexpr int LDSCTL_OFF = RING_BYTES;
constexpr int L_PADSTART = LDSCTL_OFF + 512;
constexpr int L_TILE_E = L_PADSTART + 1536;
constexpr int L_SCAN = L_TILE_E + 3072;
constexpr int L_SMALL = L_SCAN + 1024;
constexpr int LDS_BYTES = 147456;
static_assert(L_SMALL + 256 <= LDS_BYTES, "LDS map");

#define GAS __attribute__((address_space(1)))
#define CAS __attribute__((address_space(4)))
#define LAS __attribute__((address_space(3)))
typedef unsigned short bf16;
typedef unsigned v4u __attribute__((ext_vector_type(4)));
typedef float f32x4 __attribute__((ext_vector_type(4)));
typedef short bf16x8 __attribute__((ext_vector_type(8)));
#define LDS_WAIT() asm volatile("s_waitcnt lgkmcnt(0)" ::: "memory")
#define VM_WAIT() asm volatile("s_waitcnt vmcnt(0)" ::: "memory")
__device__ __forceinline__ unsigned f2bf(float f) { unsigned u = __builtin_bit_cast(unsigned, f); return (u + 0x7fffu + ((u >> 16) & 1u)) >> 16; }
__device__ __forceinline__ unsigned pk2(float lo, float hi) { return f2bf(lo) | (f2bf(hi) << 16); }
__device__ __forceinline__ float bf_lo(unsigned w) { return __builtin_bit_cast(float, w << 16); }
__device__ __forceinline__ float bf_hi(unsigned w) { return __builtin_bit_cast(float, w & 0xffff0000u); }

#define XB_TMO      128
#define XB_XCNT(j)  (256  + 64 * (j))
#define XB_XSUB(j)  (1280 + 64 * (j))
#define XB_XGEN(j)  (2304 + 64 * (j))
#define XB_TOP      3328
#define XB_TOPGEN   3392
#define XCD_BAR_WORDS 3456
#define XB_SPIN_CAP (1u << 20)
__device__ __forceinline__ unsigned xb_ld(unsigned* p)              { return __hip_atomic_load(p, __ATOMIC_RELAXED, __HIP_MEMORY_SCOPE_AGENT); }
__device__ __forceinline__ unsigned xb_add(unsigned* p, unsigned v) { return __hip_atomic_fetch_add(p, v, __ATOMIC_RELAXED, __HIP_MEMORY_SCOPE_AGENT); }
__device__ __forceinline__ unsigned xb_xcc_id() { return (unsigned)__builtin_amdgcn_s_getreg((3 << 11) | 20) & 0xFu; }
#define XB_SPIN(cond, bar) do { unsigned _sp = 0; while (cond) { __builtin_amdgcn_s_sleep(1); \
    if ((++_sp & 255u) == 0u) { if (xb_ld(&(bar)[XB_TMO])) break; if (_sp > XB_SPIN_CAP) { atomicAdd(&(bar)[XB_TMO], 1u); break; } } } } while (0)
struct XcdBarrier { unsigned* bar; unsigned x; volatile LAS unsigned* st; };
__device__ __forceinline__ XcdBarrier xcd_barrier_post(unsigned* bar, volatile LAS unsigned* st) {
    XcdBarrier b; b.bar = bar; b.x = xb_xcc_id(); b.st = st;
    if (threadIdx.x == 0) (void)xb_add(&bar[XB_XCNT(b.x)], 1u);
    return b;
}
__device__ __forceinline__ void xcd_barrier_complete(unsigned* bar, unsigned x, unsigned& nloc, unsigned& nx) {
    const unsigned G = gridDim.x * gridDim.y * gridDim.z;
    unsigned sum, cnt, mine, sp = 0u;
    for (;;) {
        sum = 0u; cnt = 0u; mine = 0u;
#pragma unroll
        for (unsigned j = 0; j < 16; ++j) { const unsigned c = xb_ld(&bar[XB_XCNT(j)]); sum += c; cnt += (c > 0u) ? 1u : 0u; mine = (j == x) ? c : mine; }
        if (sum == G) break;
        __builtin_amdgcn_s_sleep(1);
        if ((++sp & 255u) == 0u) { if (xb_ld(&bar[XB_TMO])) break; if (sp > XB_SPIN_CAP) { atomicAdd(&bar[XB_TMO], 1u); break; } }
    }
    nloc = mine > 0u ? mine : 1u; nx = cnt > 0u ? cnt : 1u;
}
__device__ __forceinline__ void xcd_barrier(const XcdBarrier& b) {
    asm volatile("s_waitcnt vmcnt(0)" ::: "memory");
    __syncthreads();
    if (threadIdx.x == 0) {
        unsigned* bar = b.bar;
        __builtin_amdgcn_s_waitcnt(0);
        unsigned nloc = b.st[0], nx = b.st[1];
        if (nloc == 0u) { xcd_barrier_complete(bar, b.x, nloc, nx); b.st[0] = nloc; b.st[1] = nx; }
        const unsigned old = xb_add(&bar[XB_XSUB(b.x)], 1u);
        const unsigned gen = old / nloc;
        if (old + 1u == (gen + 1u) * nloc) {
            __builtin_amdgcn_fence(__ATOMIC_RELEASE, "agent");
            asm volatile("s_waitcnt vmcnt(0)" ::: "memory");
            const unsigned og = xb_add(&bar[XB_TOP], 1u);
            const unsigned tg = og / nx;
            if (og + 1u == (tg + 1u) * nx) xb_add(&bar[XB_TOPGEN], 1u);
            else XB_SPIN(xb_ld(&bar[XB_TOPGEN]) == tg, bar);
            __builtin_amdgcn_fence(__ATOMIC_ACQUIRE, "agent");
            xb_add(&bar[XB_XGEN(b.x)], 1u);
            asm volatile("s_waitcnt vmcnt(0)" ::: "memory");
        } else {
            XB_SPIN(xb_ld(&bar[XB_XGEN(b.x)]) == gen, bar);
            __builtin_amdgcn_fence(__ATOMIC_ACQUIRE, "agent");
            asm volatile("s_waitcnt vmcnt(0)" ::: "memory");
        }
    }
    __syncthreads();
}

struct Args { const float* in[36]; float* out; unsigned char* ws; int ph_lo, ph_hi; };

__device__ __forceinline__ int launder_v(int x) { asm volatile("" : "+v"(x)); return x; }
__device__ __forceinline__ const CAS Args* launder_ka(const CAS Args* p) { asm volatile("" : "+s"(p)); return p; }

struct Frame {
    LAS unsigned char* lds; char* ldsg;
    unsigned* ctl;
    unsigned char* ws;
    int tid, lane, wave, vcu, G;
    int gw, NGW, gt, NGT;
};

__device__ __forceinline__ float wave_sum(float v) {
#pragma unroll
    for (int o = 1; o < 64; o <<= 1) v += __shfl_xor(v, o);
    return v;
}

__device__ __forceinline__ void transpose_item(const float* W, int Nsrc, int K, int k0, int srccol, bf16* WTrow0, LAS float* scr, int lane) {
#pragma unroll 8
    for (int i = 0; i < 32; ++i) { const int kk = 2 * i + (lane >> 5); scr[kk * 33 + (lane & 31)] = W[(size_t)(k0 + kk) * Nsrc + srccol]; }
    LDS_WAIT(); asm volatile("" ::: "memory");
    const int c = lane & 7;
#pragma unroll
    for (int j = 0; j < 4; ++j) { const int n = (lane >> 3) + 8 * j; const LAS float* s = scr + (8 * c) * 33 + n;
        v4u o; o.x = pk2(s[0 * 33], s[1 * 33]); o.y = pk2(s[2 * 33], s[3 * 33]); o.z = pk2(s[4 * 33], s[5 * 33]); o.w = pk2(s[6 * 33], s[7 * 33]);
        *(v4u*)(WTrow0 + (size_t)n * K + k0 + 8 * c) = o; }
    LDS_WAIT(); asm volatile("" ::: "memory");
}
__device__ __forceinline__ void conv_dense_item(const float* W, int K, int N, bf16* WT, int r, int plo, int phi, LAS float* scr, int lane) {
    const int nblk = N / 32, kb = r / nblk, nb = r % nblk, n = nb * 32 + (lane & 31);
    int src = n; if (n >= plo && n < phi) { const int j = n & 63; src = (n & ~63) + (j >> 1) + 32 * (j & 1); }
    transpose_item(W, N, K, kb * 64, src, WT + (size_t)nb * 32 * K, scr, lane);
}
__device__ __forceinline__ void conv_expert_item(const float* Wg, const float* Wu, const float* Wd, bf16* egu, bf16* ed, int q, LAS float* scr, int lane) {
    if (q < 256) { const int kb = q >> 4, nb = q & 15, n0 = nb * 32, pn = n0 >> 8, half = (n0 >> 7) & 1, j0 = n0 & 127;
        transpose_item(half ? Wu : Wg, 256, 1024, kb * 64, 128 * pn + j0 + (lane & 31), egu + (size_t)n0 * 1024, scr, lane); }
    else { const int qq = q - 256, kb = qq >> 5, nb = qq & 31;
        transpose_item(Wd, 1024, 256, kb * 64, nb * 32 + (lane & 31), ed + (size_t)nb * 32 * 256, scr, lane); }
}
__device__ __forceinline__ void conv_experts(Frame& F, const float* g, const float* u, const float* d, const float* sg, const float* su, const float* sd) {
    LAS float* scr = (LAS float*)(F.lds + RING_OFF + F.wave * 16384);
    bf16* EGU = (bf16*)(F.ws + WS_EGU); bf16* ED = (bf16*)(F.ws + WS_ED);
    for (int it = F.gw; it < 257 * 384; it += F.NGW) {
        const int e = it / 384, q = it % 384;
        const float* Wg = e < 256 ? g + (size_t)e * 1024 * 256 : sg; const float* Wu = e < 256 ? u + (size_t)e * 1024 * 256 : su; const float* Wd = e < 256 ? d + (size_t)e * 256 * 1024 : sd;
        conv_expert_item(Wg, Wu, Wd, EGU + (size_t)e * 512 * 1024, ED + (size_t)e * 1024 * 256, q, scr, F.lane);
    }
}

__device__ __forceinline__ void build_tiles(Frame& F, const unsigned* counts) {
    LAS int* sc = (LAS int*)(F.lds + L_SCAN); LAS int* ps = (LAS int*)(F.lds + L_PADSTART); LAS unsigned short* te = (LAS unsigned short*)(F.lds + L_TILE_E);
    int p = 0;
    if (F.tid < 256) { p = ((int)counts[F.tid] + 255) & ~255; sc[F.tid] = p; }
    __syncthreads();
    for (int off = 1; off < 256; off <<= 1) { int v = 0; if (F.tid < 256 && F.tid >= off) v = sc[F.tid - off]; __syncthreads(); if (F.tid < 256) sc[F.tid] += v; __syncthreads(); }
    if (F.tid < 256) { const int incl = sc[F.tid], start = incl - p; ps[F.tid] = start; if (F.tid == 255) ps[256] = incl;
        for (int r = start >> 8; r < (incl >> 8); ++r) te[r] = (unsigned short)F.tid; }
    __syncthreads();
}
using pg8::Unit;
struct EpiProj {
    static constexpr bool PERM = true;
    bf16* O; int ldc; unsigned ropemask, scalemask; const float* rope;
    __device__ __forceinline__ void operator()(const f32x4 (&acc)[2][2][4][2], const Unit& u, int wr, int wc, int fr, int fq) const {
        const int row0 = u.pm * 256 + wr * 64 + fr, col0 = u.pn * 256 + wc * 32 + 8 * fq;
        const bool dorope = (ropemask >> u.pn) & 1u; const float sc = ((scalemask >> u.pn) & 1u) ? C2 : 1.f;
        const int i0 = 16 * (wc & 1) + 4 * fq;
#pragma unroll
        for (int ai = 0; ai < 2; ++ai)
#pragma unroll
            for (int m = 0; m < 4; ++m) { const int row = row0 + ai * 128 + m * 16;
                f32x4 cs0 = {1.f, 0.f, 1.f, 0.f}, cs1 = {1.f, 0.f, 1.f, 0.f};
                if (dorope) { const f32x4* tp = (const f32x4*)(rope + ((size_t)(row & (SEQ - 1)) * 32 + i0) * 2); cs0 = tp[0]; cs1 = tp[1]; }
                bf16* rowp = O + (size_t)row * ldc + col0;
#pragma unroll
                for (int bj = 0; bj < 2; ++bj) { const f32x4 a = acc[ai][bj][m][0], b = acc[ai][bj][m][1]; f32x4 v0, v1;
                    v0[0] = a[0] * cs0[0] - a[1] * cs0[1]; v0[1] = a[1] * cs0[0] + a[0] * cs0[1]; v0[2] = a[2] * cs0[2] - a[3] * cs0[3]; v0[3] = a[3] * cs0[2] + a[2] * cs0[3];
                    v1[0] = b[0] * cs1[0] - b[1] * cs1[1]; v1[1] = b[1] * cs1[0] + b[0] * cs1[1]; v1[2] = b[2] * cs1[2] - b[3] * cs1[3]; v1[3] = b[3] * cs1[2] + b[2] * cs1[3];
                    v0 = v0 * sc; v1 = v1 * sc;
                    v4u w; w.x = pg8::cvt_pk_bf16(v0[0], v0[1]); w.y = pg8::cvt_pk_bf16(v0[2], v0[3]); w.z = pg8::cvt_pk_bf16(v1[0], v1[1]); w.w = pg8::cvt_pk_bf16(v1[2], v1[3]);
                    *(v4u*)(rowp + bj * 128) = w; } }
    }
};
struct EpiRes {
    static constexpr bool PERM = false;
    float* C; int ldc; const float* res; float alpha;
    __device__ __forceinline__ void operator()(const f32x4 (&acc)[2][2][4][2], const Unit& u, int wr, int wc, int fr, int fq) const {
        const int row0 = u.pm * 256 + wr * 64 + fr, col0 = u.pn * 256 + wc * 32 + 4 * fq;
#pragma unroll
        for (int ai = 0; ai < 2; ++ai)
#pragma unroll
            for (int m = 0; m < 4; ++m) { const size_t ro = (size_t)(row0 + ai * 128 + m * 16) * ldc + col0;
#pragma unroll
                for (int bj = 0; bj < 2; ++bj)
#pragma unroll
                    for (int n = 0; n < 2; ++n) { f32x4 v = acc[ai][bj][m][n];
                        if (res) { const f32x4 r = *(const f32x4*)(res + ro + bj * 128 + n * 16); v = v + r * alpha; }
                        *(f32x4*)(C + ro + bj * 128 + n * 16) = v; } }
    }
};
struct EpiSwiGLU {
    static constexpr bool PERM = true;
    bf16* H;
    __device__ __forceinline__ void operator()(const f32x4 (&acc)[2][2][4][2], const Unit& u, int wr, int wc, int fr, int fq) const {
        const int row0 = u.pm * 256 + wr * 64 + fr, col0 = u.pn * 128 + wc * 32 + 8 * fq;
#pragma unroll
        for (int ai = 0; ai < 2; ++ai)
#pragma unroll
            for (int m = 0; m < 4; ++m) { bf16* rowp = H + (size_t)(row0 + ai * 128 + m * 16) * 256 + col0; float h[8];
#pragma unroll
                for (int n = 0; n < 2; ++n)
#pragma unroll
                    for (int x = 0; x < 4; ++x) { const float g = acc[ai][0][m][n][x], up = acc[ai][1][m][n][x];
                        h[n * 4 + x] = g * __builtin_amdgcn_rcpf(1.f + __builtin_amdgcn_exp2f(-g * LOG2E)) * up; }
                v4u w; w.x = pg8::cvt_pk_bf16(h[0], h[1]); w.y = pg8::cvt_pk_bf16(h[2], h[3]); w.z = pg8::cvt_pk_bf16(h[4], h[5]); w.w = pg8::cvt_pk_bf16(h[6], h[7]);
                *(v4u*)rowp = w; }
    }
};
struct EpiDown {
    static constexpr bool PERM = true;
    bf16* YS; const int* dest;
    __device__ __forceinline__ void operator()(const f32x4 (&acc)[2][2][4][2], const Unit& u, int wr, int wc, int fr, int fq) const {
        const int row0 = u.pm * 256 + wr * 64 + fr, col0 = u.pn * 256 + wc * 32 + 8 * fq;
        int dr[2][4];
#pragma unroll
        for (int ai = 0; ai < 2; ++ai)
#pragma unroll
            for (int m = 0; m < 4; ++m) dr[ai][m] = dest[row0 + ai * 128 + m * 16];
#pragma unroll
        for (int ai = 0; ai < 2; ++ai)
#pragma unroll
            for (int m = 0; m < 4; ++m) { if (dr[ai][m] >= 0) { bf16* rowp = YS + (size_t)dr[ai][m] * 1024 + col0;
#pragma unroll
                for (int bj = 0; bj < 2; ++bj) { const f32x4 v0 = acc[ai][bj][m][0], v1 = acc[ai][bj][m][1];
                    v4u w; w.x = pg8::cvt_pk_bf16(v0[0], v0[1]); w.y = pg8::cvt_pk_bf16(v0[2], v0[3]); w.z = pg8::cvt_pk_bf16(v1[0], v1[1]); w.w = pg8::cvt_pk_bf16(v1[2], v1[3]);
                    *(v4u*)(rowp + bj * 128) = w; } } }
    }
};
template <bool GATHER_, int SHIFT> struct MoeOrder {
    static constexpr bool GATHER = GATHER_;
    int R, G, c, K; const LAS unsigned short* te; const int* gtok; const char* A; const char* B; size_t bexp, btile;
    __device__ __forceinline__ bool next(int i, Unit& u) const {
        const int U = i * G + c, rp = U >> SHIFT; if (rp >= R + T / 256) return false;
        u.pn = U & ((1 << SHIFT) - 1); const bool sh = rp >= R; u.pm = sh ? NTILE_E + (rp - R) : rp; u.e = sh ? 256 : (int)te[sh ? 0 : rp];
        u.A = GATHER ? A : A + (size_t)u.pm * 256 * K * 2; u.B = B + (size_t)u.e * bexp + (size_t)u.pn * btile; return true;
    }
    __device__ __forceinline__ int arow(const Unit& u, int row) const { return gtok[u.pm * 256 + row]; }
};

struct NaMask {
    int r, c, kr0, rs, cs; const float* bias;
    __device__ __forceinline__ void operator()(att::f32x16& p0, att::f32x16& p1, int t, int r32, int hi) const {
        const int kr = kr0 + t; const bool rowok = (kr >= rs) && (kr < rs + 8);
        if (!rowok) {
#pragma unroll
            for (int q = 0; q < 16; ++q) { p0[q] = att::NEGV; p1[q] = att::NEGV; }
        } else { const float* bp = bias + (kr - r + 7) * 31 + 15 - c;
#pragma unroll
            for (int q = 0; q < 16; ++q) { const int k0 = att::crow(q, hi), k1 = k0 + 32;
                p0[q] = (k0 >= cs && k0 < cs + 16) ? p0[q] + bp[k0] : att::NEGV;
                p1[q] = (k1 >= cs && k1 < cs + 16) ? p1[q] + bp[k1] : att::NEGV; } }
    }
};
struct SwaMask {
    int qpos, k0;
    __device__ __forceinline__ void operator()(att::f32x16& p0, att::f32x16& p1, int t, int r32, int hi) const {
        const int base = k0 + 64 * t - qpos;
#pragma unroll
        for (int q = 0; q < 16; ++q) { const int d0 = base + att::crow(q, hi), d1 = d0 + 32;
            p0[q] = (d0 >= -128 && d0 <= 128) ? p0[q] : att::NEGV;
            p1[q] = (d1 >= -128 && d1 <= 128) ? p1[q] : att::NEGV; }
    }
};
__device__ __forceinline__ void na_unit(Frame& F, int b, int h, int rb, const bf16* hcat, bf16* attout, const float* rpb) {
    char* lds = F.ldsg + RING_OFF;
    const int tid = launder_v((int)threadIdx.x), lane = tid & 63, r32 = lane & 31, hi = lane >> 5, w = __builtin_amdgcn_readfirstlane(tid >> 6);
    const int r0 = rb * 4, r = r0 + (w >> 1), c = (w & 1) * 32 + r32;
    int kr0 = r0 - 4; kr0 = kr0 < 0 ? 0 : (kr0 > 116 ? 116 : kr0);
    float* bias = (float*)(lds + att::L_BIAS);
    __syncthreads();
    if (tid < 465) bias[tid] = rpb[h * 465 + tid] * LOG2E;
    const size_t tok = (size_t)b * SEQ + (size_t)r * 64 + c;
    const bf16* Ql = hcat + tok * 3072 + h * 64 + hi * 8;
    att::bf16x8 qr[4];
#pragma unroll
    for (int d0 = 0; d0 < 4; ++d0) qr[d0] = *reinterpret_cast<const att::bf16x8*>(Ql + d0 * 16);
    const bf16* Kh = hcat + ((size_t)b * SEQ + (size_t)kr0 * 64) * 3072 + 512 + h * 64;
    const bf16* Vh = Kh + 512;
    NaMask mk; mk.r = r; mk.c = c; mk.kr0 = kr0; { int rs = r - 4; mk.rs = rs < 0 ? 0 : (rs > 120 ? 120 : rs); int cs = c - 8; mk.cs = cs < 0 ? 0 : (cs > 48 ? 48 : cs); } mk.bias = bias;
    att::f32x16 o[2]; o[0] = att::f32x16{}; o[1] = att::f32x16{};
    float m_reg = att::MINIT, l_reg = 0.f;
    att::attn_tiles<64, NaMask>(o, m_reg, l_reg, qr, Kh, Vh, 3072, 12, mk, lds, tid);
    att::normalize_rows<2>(o, l_reg, lds, tid);
    const size_t tok0 = (size_t)b * SEQ + (size_t)r * 64 + (w & 1) * 32;
    att::store_rows<64>(o, attout + tok0 * 1024 + h * 64, 1024, lds, tid);
}
__device__ __forceinline__ void swa_unit(Frame& F, int b, int hq, int qb, const bf16* hcat, bf16* attout, const float* sinks) {
    char* lds = F.ldsg + RING_OFF;
    const int tid = launder_v((int)threadIdx.x), lane = tid & 63, r32 = lane & 31, hi = lane >> 5, w = __builtin_amdgcn_readfirstlane(tid >> 6);
    const int q0 = qb * 256, qpos = q0 + w * 32 + r32;
    const int k0 = q0 - 128 < 0 ? 0 : q0 - 128, k1 = q0 + 384 > SEQ ? SEQ : q0 + 384, NT = (k1 - k0) / 64;
    __syncthreads();
    const size_t tok = (size_t)b * SEQ + qpos;
    const bf16* Ql = hcat + tok * 1536 + hq * 64 + hi * 8;
    att::bf16x8 qr[4];
#pragma unroll
    for (int d0 = 0; d0 < 4; ++d0) qr[d0] = *reinterpret_cast<const att::bf16x8*>(Ql + d0 * 16);
    const int kvh = hq >> 2;
    const bf16* Kh = hcat + ((size_t)b * SEQ + k0) * 1536 + 1024 + kvh * 64;
    const bf16* Vh = Kh + 256;
    SwaMask mk; mk.qpos = qpos; mk.k0 = k0;
    att::f32x16 o[2]; o[0] = att::f32x16{}; o[1] = att::f32x16{};
    float m_reg = sinks[hq] * LOG2E, l_reg = 1.f;
    att::attn_tiles<64, SwaMask>(o, m_reg, l_reg, qr, Kh, Vh, 1536, NT, mk, lds, tid);
    att::normalize_rows<2>(o, l_reg, lds, tid);
    const size_t tok0 = (size_t)b * SEQ + q0 + w * 32;
    att::store_rows<64>(o, attout + tok0 * 1024 + hq * 64, 1024, lds, tid);
}
__device__ __forceinline__ void diff_unit(Frame& F, int b, int h, int qb, const bf16* hcat, bf16* attout, float lam, const float* subg, float* stash) {
    char* lds = F.ldsg + RING_OFF;
    const int tid = launder_v((int)threadIdx.x), lane = tid & 63, r32 = lane & 31, hi = lane >> 5, w = __builtin_amdgcn_readfirstlane(tid >> 6);
    const size_t tok = (size_t)b * SEQ + qb * 256 + w * 32 + r32;
    f32x4* st = (f32x4*)(stash + (size_t)blockIdx.x * 32768 + (size_t)tid * 64);
    for (int map = 0; map < 2; ++map) {
        __syncthreads();
        const bf16* Ql = hcat + tok * 3072 + 1536 + h * 128 + map * 64 + hi * 8;
        att::bf16x8 qr[4];
        char* qlds = lds + att::L_STG + w * 8192;
#pragma unroll
        for (int d0 = 0; d0 < 4; ++d0) { qr[d0] = *reinterpret_cast<const att::bf16x8*>(Ql + d0 * 16); *reinterpret_cast<att::bf16x8*>(qlds + d0 * 1024 + hi * 512 + r32 * 16) = qr[d0]; }
        asm volatile("s_waitcnt lgkmcnt(0)" ::: "memory");
        const int qa = (int)(uintptr_t)qlds + hi * 512 + r32 * 16;
        const bf16* Kh = hcat + (size_t)b * SEQ * 3072 + 2048 + h * 128 + map * 64;
        const bf16* Vh = hcat + (size_t)b * SEQ * 3072 + 2560 + h * 128;
        att::f32x16 o[4]; o[0] = att::f32x16{}; o[1] = att::f32x16{}; o[2] = att::f32x16{}; o[3] = att::f32x16{};
        float m_reg = att::MINIT, l_reg = 0.f;
        att::attn_tiles<128, att::NoMask, true>(o, m_reg, l_reg, qr, Kh, Vh, 3072, SEQ / 64, att::NoMask(), lds, tid, qa);
        att::normalize_rows<4>(o, l_reg, lds, tid);
        if (map == 0) {
#pragma unroll
            for (int d = 0; d < 4; ++d)
#pragma unroll
                for (int q = 0; q < 4; ++q) st[d * 4 + q] = (f32x4){o[d][4 * q], o[d][4 * q + 1], o[d][4 * q + 2], o[d][4 * q + 3]};
        } else {
            float ss[16];
#pragma unroll
            for (int q = 0; q < 16; ++q) ss[q] = 0.f;
#pragma unroll
            for (int d = 0; d < 4; ++d)
#pragma unroll
                for (int q4 = 0; q4 < 4; ++q4) { const f32x4 s4 = st[d * 4 + q4];
#pragma unroll
                    for (int x = 0; x < 4; ++x) { const int q = 4 * q4 + x; const float v = s4[x] - lam * o[d][q]; o[d][q] = v; ss[q] += v * v; } }
#pragma unroll
            for (int q = 0; q < 16; ++q) { float s = ss[q]; s += __shfl_xor(s, 1); s += __shfl_xor(s, 2); s += __shfl_xor(s, 4); s += __shfl_xor(s, 8); s += __shfl_xor(s, 16);
                ss[q] = __builtin_amdgcn_rsqf(s * (1.f / 128.f) + LN_EPS) * (1.f - LAMBDA_INIT0); }
#pragma unroll
            for (int d = 0; d < 4; ++d) { const float g = subg[d * 32 + r32];
#pragma unroll
                for (int q = 0; q < 16; ++q) o[d][q] *= ss[q] * g; }
            const size_t tok0 = (size_t)b * SEQ + qb * 256 + w * 32;
            att::store_rows<128>(o, attout + tok0 * 1024 + 512 + h * 128, 1024, lds, tid);
        }
    }
}

__device__ __forceinline__ void ln_rows(Frame& F, const float* src, float* dst, bf16* dstb, const float* g, const float* bb) {
    for (int t = F.gw; t < T; t += F.NGW) {
        float v[16]; float s = 0.f;
#pragma unroll
        for (int j = 0; j < 2; ++j) { const f32x4* p = (const f32x4*)(src + (size_t)t * DM + 8 * F.lane + 512 * j); const f32x4 a = p[0], b = p[1];
#pragma unroll
            for (int x = 0; x < 4; ++x) { v[j * 8 + x] = a[x]; v[j * 8 + 4 + x] = b[x]; } }
#pragma unroll
        for (int i = 0; i < 16; ++i) s += v[i];
        const float mean = wave_sum(s) * (1.f / DM); float s2 = 0.f;
#pragma unroll
        for (int i = 0; i < 16; ++i) { v[i] -= mean; s2 += v[i] * v[i]; }
        const float rstd = __builtin_amdgcn_rsqf(wave_sum(s2) * (1.f / DM) + LN_EPS);
#pragma unroll
        for (int j = 0; j < 2; ++j) { const int col = 8 * F.lane + 512 * j; const f32x4* gp = (const f32x4*)(g + col); const f32x4* bp = (const f32x4*)(bb + col);
            const f32x4 g0 = gp[0], g1 = gp[1], b0 = bp[0], b1 = bp[1]; f32x4 o0, o1;
#pragma unroll
            for (int x = 0; x < 4; ++x) { o0[x] = v[j * 8 + x] * rstd * g0[x] + b0[x]; o1[x] = v[j * 8 + 4 + x] * rstd * g1[x] + b1[x]; }
            f32x4* dp = (f32x4*)(dst + (size_t)t * DM + col); dp[0] = o0; dp[1] = o1;
            if (dstb) { v4u wv; wv.x = pk2(o0[0], o0[1]); wv.y = pk2(o0[2], o0[3]); wv.z = pk2(o1[0], o1[1]); wv.w = pk2(o1[2], o1[3]); *(v4u*)(dstb + (size_t)t * DM + col) = wv; } }
    }
}
__device__ __forceinline__ void combine_rows(Frame& F, const float* x1, const bf16* ys, const float* selg, float* dst, bf16* dstb, const float* g, const float* bb) {
    for (int t = F.gw; t < T; t += F.NGW) {
        float v[16];
#pragma unroll
        for (int j = 0; j < 2; ++j) { const f32x4* p = (const f32x4*)(x1 + (size_t)t * DM + 8 * F.lane + 512 * j); const f32x4 a = p[0], b = p[1];
#pragma unroll
            for (int x = 0; x < 4; ++x) { v[j * 8 + x] = a[x] * DN_ALPHA; v[j * 8 + 4 + x] = b[x] * DN_ALPHA; } }
#pragma unroll
        for (int k = 0; k < 9; ++k) { const float gk = k < 8 ? selg[(size_t)t * 8 + k] : 1.f; const size_t row = k < 8 ? (size_t)t * 8 + k : (size_t)T * 8 + t;
#pragma unroll
            for (int j = 0; j < 2; ++j) { const v4u wv = *(const v4u*)(ys + row * DM + 8 * F.lane + 512 * j);
                v[j * 8 + 0] += gk * bf_lo(wv.x); v[j * 8 + 1] += gk * bf_hi(wv.x); v[j * 8 + 2] += gk * bf_lo(wv.y); v[j * 8 + 3] += gk * bf_hi(wv.y);
                v[j * 8 + 4] += gk * bf_lo(wv.z); v[j * 8 + 5] += gk * bf_hi(wv.z); v[j * 8 + 6] += gk * bf_lo(wv.w); v[j * 8 + 7] += gk * bf_hi(wv.w); } }
        float s = 0.f;
#pragma unroll
        for (int i = 0; i < 16; ++i) s += v[i];
        const float mean = wave_sum(s) * (1.f / DM); float s2 = 0.f;
#pragma unroll
        for (int i = 0; i < 16; ++i) { v[i] -= mean; s2 += v[i] * v[i]; }
        const float rstd = __builtin_amdgcn_rsqf(wave_sum(s2) * (1.f / DM) + LN_EPS);
#pragma unroll
        for (int j = 0; j < 2; ++j) { const int col = 8 * F.lane + 512 * j; const f32x4* gp = (const f32x4*)(g + col); const f32x4* bp = (const f32x4*)(bb + col);
            const f32x4 g0 = gp[0], g1 = gp[1], b0 = bp[0], b1 = bp[1]; f32x4 o0, o1;
#pragma unroll
            for (int x = 0; x < 4; ++x) { o0[x] = v[j * 8 + x] * rstd * g0[x] + b0[x]; o1[x] = v[j * 8 + 4 + x] * rstd * g1[x] + b1[x]; }
            f32x4* dp = (f32x4*)(dst + (size_t)t * DM + col); dp[0] = o0; dp[1] = o1;
            if (dstb) { v4u wv; wv.x = pk2(o0[0], o0[1]); wv.y = pk2(o0[2], o0[3]); wv.z = pk2(o1[0], o1[1]); wv.w = pk2(o1[2], o1[3]); *(v4u*)(dstb + (size_t)t * DM + col) = wv; } }
    }
}
__device__ __forceinline__ void route_rows(Frame& F, const float* logits, const float* rbias, unsigned* counts, int* sel_e, float* sel_g, int* sel_pos) {
    const int lane = F.lane;
    const f32x4 bv = *(const f32x4*)(rbias + 4 * lane);
    for (int t = F.gw; t < T; t += F.NGW) {
        const f32x4 lg = *(const f32x4*)(logits + (size_t)t * NEXP + 4 * lane);
        float s[4], c[4];
#pragma unroll
        for (int j = 0; j < 4; ++j) { s[j] = 1.f / (1.f + __expf(-lg[j])); c[j] = s[j] + bv[j]; }
        float m1 = fmaxf(c[0], c[1]), m2 = fminf(c[0], c[1]);
        { const float a = fmaxf(c[2], c[3]), bb2 = fminf(c[2], c[3]); const float n1 = fmaxf(m1, a); m2 = fmaxf(fminf(m1, a), fmaxf(m2, bb2)); m1 = n1; }
#pragma unroll
        for (int off = 1; off < 8; off <<= 1) { const float o1 = __shfl_xor(m1, off), o2 = __shfl_xor(m2, off); const float n1 = fmaxf(m1, o1); m2 = fmaxf(fminf(m1, o1), fmaxf(m2, o2)); m1 = n1; }
        const float gs = m1 + m2; const int mygrp = lane >> 3; int rank = 0;
#pragma unroll
        for (int j = 0; j < 8; ++j) { const float gj = __shfl(gs, j * 8); rank += (gj > gs || (gj == gs && j < mygrp)) ? 1 : 0; }
        const bool selg = rank < 4;
#pragma unroll
        for (int j = 0; j < 4; ++j) if (!selg) c[j] = -INFINITY;
        unsigned taken = 0u; int my_e = 0; float my_s = 0.f, ssum = 0.f;
#pragma unroll 1
        for (int k = 0; k < TOPK; ++k) {
            float bvv = -INFINITY; int bi = 1 << 20;
#pragma unroll
            for (int j = 0; j < 4; ++j) { const bool ok = !((taken >> j) & 1u) && (c[j] > bvv); if (ok) { bvv = c[j]; bi = 4 * lane + j; } }
#pragma unroll
            for (int off = 1; off < 64; off <<= 1) { const float ov = __shfl_xor(bvv, off); const int oi = __shfl_xor(bi, off); if (ov > bvv || (ov == bvv && oi < bi)) { bvv = ov; bi = oi; } }
            const int jj = bi & 3; const bool mine = (bi >> 2) == lane;
            float sc = mine ? (jj == 0 ? s[0] : jj == 1 ? s[1] : jj == 2 ? s[2] : s[3]) : 0.f;
            sc = __shfl(sc, bi >> 2);
            if (mine) taken |= 1u << jj;
            ssum += sc;
            if (lane == k) { my_e = bi; my_s = sc; }
        }
        if (lane < TOPK) {
            const int pos = (int)__hip_atomic_fetch_add(counts + my_e, 1u, __ATOMIC_RELAXED, __HIP_MEMORY_SCOPE_AGENT);
            sel_e[(size_t)t * 8 + lane] = my_e; sel_g[(size_t)t * 8 + lane] = my_s / ssum * 2.5f; sel_pos[(size_t)t * 8 + lane] = pos;
        }
    }
}

#ifndef ATT_SEL
#define ATT_SEL 7
#endif
__device__ __forceinline__ void make_frame(Frame& F, unsigned char* lds_raw) {
    const CAS Args* ka = launder_ka((const CAS Args*)__builtin_amdgcn_kernarg_segment_ptr());
    F.lds = (LAS unsigned char*)lds_raw; F.ldsg = (char*)lds_raw;
    F.tid = launder_v((int)threadIdx.x); F.lane = F.tid & 63; F.wave = __builtin_amdgcn_readfirstlane(F.tid >> 6);
    F.G = gridDim.x; { const int bx = blockIdx.x; F.vcu = (F.G % 8 == 0) ? (bx % 8) * (F.G / 8) + bx / 8 : bx; }
    F.gw = F.vcu * NWAVES + F.wave; F.NGW = F.G * NWAVES; F.gt = F.vcu * (NWAVES * 64) + F.tid; F.NGT = F.G * NWAVES * 64;
    F.ws = ka->ws; F.ctl = (unsigned*)(ka->ws + WS_CTL);
}
#define WSP(type, off) ((type*)(F.ws + (off)))
__global__ void __launch_bounds__(NWAVES * 64, 2) mk_fwd(Args args) {
    extern __shared__ __attribute__((aligned(16))) unsigned char lds_raw[];
    volatile LAS unsigned* MISC = (volatile LAS unsigned*)((LAS unsigned char*)lds_raw + LDSCTL_OFF);
    for (int u = threadIdx.x; u < 128; u += NWAVES * 64) MISC[u] = 0u;
    __syncthreads();
    XcdBarrier bar; bar.bar = (unsigned*)(args.ws + WS_CTL) + CW_BAR; bar.x = 0; bar.st = nullptr;
    if (MK_N_LAUNCHES == 1) bar = xcd_barrier_post((unsigned*)(args.ws + WS_CTL) + CW_BAR, MISC + 8);
    const int lo = args.ph_lo, hi = args.ph_hi;
#ifndef PH_MASK
#define PH_MASK 0x7ff
#endif
#define IN(k) (((PH_MASK >> ((k) % 11)) & 1) && lo <= (k) && (k) < hi)
#define SEAM(k) do { if (IN(k) && IN((k) + 1)) xcd_barrier(bar); } while (0)

    if (IN(0)) {
        Frame F; make_frame(F, lds_raw);
        const CAS Args* ka = launder_ka((const CAS Args*)__builtin_amdgcn_kernarg_segment_ptr());
        const float* const CAS* in = ka->in;
        LAS float* scr = (LAS float*)(F.lds + RING_OFF + F.wave * 16384);
        constexpr int I_IN0 = 16 * 96, I_OUT = 16 * 32, I_R = 16 * 8, I_IN1 = 16 * 48;
        constexpr int NIT = I_IN0 + I_OUT + I_R + I_IN1 + I_OUT + I_R;
        for (int it = F.gw; it < NIT; it += F.NGW) {
            int r = it;
            if (r < I_IN0) { conv_dense_item(in[1], 1024, 3072, WSP(bf16, WS_W0IN), r, 1536, 2560, scr, F.lane); continue; } r -= I_IN0;
            if (r < I_OUT) { conv_dense_item(in[2], 1024, 1024, WSP(bf16, WS_W0OUT), r, 0, 0, scr, F.lane); continue; } r -= I_OUT;
            if (r < I_R)   { conv_dense_item(in[11], 1024, 256, WSP(bf16, WS_R0), r, 0, 0, scr, F.lane); continue; } r -= I_R;
            if (r < I_IN1) { conv_dense_item(in[21], 1024, 1536, WSP(bf16, WS_W1IN), r, 0, 1280, scr, F.lane); continue; } r -= I_IN1;
            if (r < I_OUT) { conv_dense_item(in[22], 1024, 1024, WSP(bf16, WS_W1OUT), r, 0, 0, scr, F.lane); continue; } r -= I_OUT;
            conv_dense_item(in[26], 1024, 256, WSP(bf16, WS_R1), r, 0, 0, scr, F.lane);
        }
        conv_experts(F, in[13], in[14], in[15], in[16], in[17], in[18]);
        { const float* x = in[0]; bf16* XB = WSP(bf16, WS_XB);
          for (size_t i = (size_t)F.gt; i < (size_t)T * DM / 8; i += (size_t)F.NGT) { const f32x4* p = (const f32x4*)(x + i * 8); const f32x4 a = p[0], b = p[1];
              v4u wv; wv.x = pk2(a[0], a[1]); wv.y = pk2(a[2], a[3]); wv.z = pk2(b[0], b[1]); wv.w = pk2(b[2], b[3]); *(v4u*)(XB + i * 8) = wv; } }
        { float* ROPE = WSP(float, WS_ROPE);
          for (int i = F.gt; i < SEQ * 32; i += F.NGT) { const int pos = i >> 5, fi = i & 31;
            const float inv = 1.0f / __powf(10000.f, (float)(2 * fi) * (1.f / 64.f));
            const float ang = (float)pos * inv;
            const double tt = (double)ang * 0.15915494309189535; const float fr = (float)(tt - floor(tt));
            ROPE[2 * i] = __builtin_amdgcn_cosf(fr); ROPE[2 * i + 1] = __builtin_amdgcn_sinf(fr); } }
    }
    SEAM(0);
#pragma unroll 1
    for (int layer = 0; layer < 2; ++layer) {
        const int pb = layer * 11;
        if (IN(pb + 1)) {
            Frame F; make_frame(F, lds_raw);
            pg8::DenseOrder S;
            EpiProj E; E.O = WSP(bf16, WS_HCAT); E.rope = WSP(float, WS_ROPE);
            if (layer == 0) { S.init(WSP(bf16, WS_XB), F.ws + WS_W0IN, T, 3072, 1024, F.G, (int)blockIdx.x); E.ldc = 3072; E.ropemask = 0x3C0u; E.scalemask = 0x0C3u; }
            else            { S.init(WSP(bf16, WS_X1B), F.ws + WS_W1IN, T, 1536, 1024, F.G, (int)blockIdx.x); E.ldc = 1536; E.ropemask = 0x01Fu; E.scalemask = 0x00Fu; }
            pg8::gemm_phase<EpiProj, pg8::DenseOrder, true>(F.lds + RING_OFF, 1024, S, E);
        }
        SEAM(pb + 1);
        if (IN(pb + 2)) {
            Frame F; make_frame(F, lds_raw);
            const CAS Args* ka = launder_ka((const CAS Args*)__builtin_amdgcn_kernarg_segment_ptr());
            const float* const CAS* in = ka->in;
            if (layer == 0) {
                float lam;
                { const float* lq1 = in[4]; const float* lk1 = in[5]; const float* lq2 = in[6]; const float* lk2 = in[7];
                  const float a = wave_sum(lq1[F.lane] * lk1[F.lane]), b2 = wave_sum(lq2[F.lane] * lk2[F.lane]); lam = __expf(a) - __expf(b2) + LAMBDA_INIT0; }
                if (ATT_SEL & 1) for (int u = F.vcu; u < 512; u += F.G) diff_unit(F, u >> 7, (u >> 5) & 3, u & 31, WSP(bf16, WS_HCAT), WSP(bf16, WS_ATT), lam, in[8], WSP(float, WS_O1S));
                if (ATT_SEL & 2) for (int u = F.vcu; u < 1024; u += F.G) na_unit(F, u >> 8, (u >> 5) & 7, u & 31, WSP(bf16, WS_HCAT), WSP(bf16, WS_ATT), in[3]);
            } else {
                if (ATT_SEL & 4) for (int u = F.vcu; u < 2048; u += F.G) swa_unit(F, u >> 9, (u >> 5) & 15, u & 31, WSP(bf16, WS_HCAT), WSP(bf16, WS_ATT), in[23]);
            }
        }
        SEAM(pb + 2);
        if (IN(pb + 3)) {
            Frame F; make_frame(F, lds_raw);
            const CAS Args* ka = launder_ka((const CAS Args*)__builtin_amdgcn_kernarg_segment_ptr());
            pg8::DenseOrder S; S.init(WSP(bf16, WS_ATT), F.ws + (layer == 0 ? WS_W0OUT : WS_W1OUT), T, 1024, 1024, F.G, (int)blockIdx.x);
            EpiRes E; E.C = WSP(float, WS_Y); E.ldc = 1024; E.res = layer == 0 ? ka->in[0] : WSP(float, WS_X1); E.alpha = DN_ALPHA;
            pg8::gemm_phase<EpiRes, pg8::DenseOrder, true>(F.lds + RING_OFF, 1024, S, E);
        }
        SEAM(pb + 3);
        if (IN(pb + 4)) {
            Frame F; make_frame(F, lds_raw);
            const CAS Args* ka = launder_ka((const CAS Args*)__builtin_amdgcn_kernarg_segment_ptr());
            ln_rows(F, WSP(float, WS_Y), WSP(float, WS_X1), WSP(bf16, WS_X1B), ka->in[layer == 0 ? 9 : 24], ka->in[layer == 0 ? 10 : 25]);
        }
        SEAM(pb + 4);
        if (IN(pb + 5)) {
            Frame F; make_frame(F, lds_raw);
            pg8::DenseOrder S; S.init(WSP(bf16, WS_X1B), F.ws + (layer == 0 ? WS_R0 : WS_R1), T, 256, 1024, F.G, (int)blockIdx.x);
            EpiRes E; E.C = WSP(float, WS_H); E.ldc = 256; E.res = nullptr; E.alpha = 0.f;
            pg8::gemm_phase<EpiRes, pg8::DenseOrder, true>(F.lds + RING_OFF, 1024, S, E);
        }
        SEAM(pb + 5);
        if (IN(pb + 6)) {
            Frame F; make_frame(F, lds_raw);
            const CAS Args* ka = launder_ka((const CAS Args*)__builtin_amdgcn_kernarg_segment_ptr());
            route_rows(F, WSP(float, WS_H), ka->in[layer == 0 ? 12 : 27], F.ctl + CW_CNT + 256 * layer, WSP(int, WS_SEL_E), WSP(float, WS_SEL_G), WSP(int, WS_SEL_POS));
        }
        SEAM(pb + 6);
        if (IN(pb + 7)) {
            Frame F; make_frame(F, lds_raw);
            unsigned* counts = F.ctl + CW_CNT + 256 * layer;
            int* SEL_E = WSP(int, WS_SEL_E); int* SEL_POS = WSP(int, WS_SEL_POS); int* GTOK = WSP(int, WS_GTOK); int* DEST = WSP(int, WS_DEST);
            build_tiles(F, counts);
            const LAS int* ps = (const LAS int*)(F.lds + L_PADSTART);
            for (int a = F.gt; a < T * 8; a += F.NGT) { const int e = SEL_E[a]; const int slot = ps[e] + SEL_POS[a]; GTOK[slot] = a >> 3; DEST[slot] = a; }
            for (int e = F.vcu; e < NEXP; e += F.G) { const int st = ps[e] + (int)counts[e], en = ps[e + 1]; for (int s = st + F.tid; s < en; s += NWAVES * 64) { GTOK[s] = 0; DEST[s] = -1; } }
            for (int t = F.gt; t < T; t += F.NGT) { GTOK[NSLOT_MAX + t] = t; DEST[NSLOT_MAX + t] = T * 8 + t; }
        }
        SEAM(pb + 7);
        if (IN(pb + 8)) {
            Frame F; make_frame(F, lds_raw);
            build_tiles(F, F.ctl + CW_CNT + 256 * layer);
            MoeOrder<true, 1> S; S.R = ((const LAS int*)(F.lds + L_PADSTART))[256] >> 8; S.G = F.G; S.c = F.vcu; S.K = 1024; S.te = (const LAS unsigned short*)(F.lds + L_TILE_E); S.gtok = WSP(int, WS_GTOK);
            S.A = (const char*)WSP(bf16, WS_X1B); S.B = (const char*)WSP(bf16, WS_EGU); S.bexp = (size_t)512 * 1024 * 2; S.btile = (size_t)256 * 1024 * 2;
            EpiSwiGLU E; E.H = WSP(bf16, WS_H);
            pg8::gemm_phase<EpiSwiGLU, MoeOrder<true, 1>, true>(F.lds + RING_OFF, 1024, S, E);
        }
        SEAM(pb + 8);
        if (IN(pb + 9)) {
            Frame F; make_frame(F, lds_raw);
            build_tiles(F, F.ctl + CW_CNT + 256 * layer);
            MoeOrder<false, 2> S; S.R = ((const LAS int*)(F.lds + L_PADSTART))[256] >> 8; S.G = F.G; S.c = F.vcu; S.K = 256; S.te = (const LAS unsigned short*)(F.lds + L_TILE_E); S.gtok = nullptr;
            S.A = (const char*)WSP(bf16, WS_H); S.B = (const char*)WSP(bf16, WS_ED); S.bexp = (size_t)1024 * 256 * 2; S.btile = (size_t)256 * 256 * 2;
            EpiDown E; E.YS = WSP(bf16, WS_YS); E.dest = WSP(int, WS_DEST);
            pg8::gemm_phase<EpiDown, MoeOrder<false, 2>, true>(F.lds + RING_OFF, 256, S, E);
        }
        SEAM(pb + 9);
        if (IN(pb + 10)) {
            Frame F; make_frame(F, lds_raw);
            const CAS Args* ka = launder_ka((const CAS Args*)__builtin_amdgcn_kernarg_segment_ptr());
            const float* const CAS* in = ka->in;
            if (layer == 0) { combine_rows(F, WSP(float, WS_X1), WSP(bf16, WS_YS), WSP(float, WS_SEL_G), WSP(float, WS_X1), WSP(bf16, WS_X1B), in[19], in[20]);
                              conv_experts(F, in[28], in[29], in[30], in[31], in[32], in[33]); }
            else combine_rows(F, WSP(float, WS_X1), WSP(bf16, WS_YS), WSP(float, WS_SEL_G), ka->out, nullptr, in[34], in[35]);
        }
        if (layer == 0) { SEAM(pb + 10); }
    }
#undef IN
#undef SEAM
}

extern "C" void kernel_launch(void* const* d_in, const int* in_sizes, int n_in, void* d_out, int out_size, void* d_ws, size_t ws_size, hipStream_t stream) {
    static int grid = 0;
    if (grid == 0) {
        if (n_in != 36 || in_sizes[0] != T * DM || out_size != T * DM || ws_size < WS_END) { fprintf(stderr, "kernel_launch: shape/workspace mismatch (n_in %d, ws %zu, need %zu)\n", n_in, ws_size, (size_t)WS_END); grid = -1; return; }
        int dev = 0, cus = 0, per_cu = 0;
        if (hipGetDevice(&dev) != hipSuccess || hipDeviceGetAttribute(&cus, hipDeviceAttributeMultiprocessorCount, dev) != hipSuccess) { grid = -1; return; }
        if (hipFuncSetAttribute((const void*)mk_fwd, hipFuncAttributeMaxDynamicSharedMemorySize, LDS_BYTES) != hipSuccess) { fprintf(stderr, "kernel_launch: hipFuncSetAttribute failed\n"); grid = -1; return; }
        if (hipOccupancyMaxActiveBlocksPerMultiprocessor(&per_cu, (const void*)mk_fwd, NWAVES * 64, LDS_BYTES) != hipSuccess || per_cu < 1) { fprintf(stderr, "kernel_launch: occupancy query says %d\n", per_cu); }
        (void)hipGetLastError();
        grid = cus;
    }
    if (grid < 0) return;
    if (hipMemsetAsync((char*)d_ws + WS_CTL, 0, CTL_ZERO_BYTES, stream) != hipSuccess) return;
    Args a{};
    for (int i = 0; i < 36; ++i) a.in[i] = (const float*)d_in[i];
    a.out = (float*)d_out; a.ws = (unsigned char*)d_ws;
    if (MK_N_LAUNCHES == 1) { a.ph_lo = 0; a.ph_hi = NPH; hipLaunchKernelGGL(mk_fwd, dim3(grid), dim3(NWAVES * 64), LDS_BYTES, stream, a); }
    else { for (int p = 0; p < NPH; ++p) { if (p == 11) continue; a.ph_lo = p; a.ph_hi = p + 1; hipLaunchKernelGGL(mk_fwd, dim3(grid), dim3(NWAVES * 64), LDS_BYTES, stream, a); } }
}
```

```cpp
#include <hip/hip_runtime.h>
#include <cstdio>
#include <cstdint>
#define MK_N_LAUNCHES 1
namespace pg8 {
#define PG8_LAS __attribute__((address_space(3)))
typedef unsigned short bf16_t;
typedef short bf16x8 __attribute__((ext_vector_type(8)));
typedef float f32x4 __attribute__((ext_vector_type(4)));
typedef unsigned u32x4 __attribute__((ext_vector_type(4)));
constexpr int BM = 256, BK = 64, HALF = 128, HTB = HALF * BK * 2, STAGE_BYTES = 8 * HTB, NXCD = 8, WGM = 8;

__host__ __device__ __forceinline__ int lds_byte(int r, int c) { const int st = (r >> 4) * 2 + (c >> 5), rr = r & 15, cc = c & 31, ob = rr * 64 + cc * 2; return st * 1024 + (ob ^ (((ob >> 9) & 1) << 5)); }
__host__ __device__ __forceinline__ void stage_rc(int b, int& R, int& C) { const int st = b / 1024, sb = b % 1024, swz = sb ^ (((sb >> 9) & 1) << 5); R = (st >> 1) * 16 + swz / 64; C = (st & 1) * 32 + (swz % 64) / 2; }
__host__ __device__ __forceinline__ int perm32(int rho) { const int n = rho >> 4, i = rho & 15; return 8 * (i >> 2) + 4 * n + (i & 3); }

struct Unit { int pm, pn, e; const char* A; const char* B; };

__device__ __forceinline__ unsigned cvt_pk_bf16(float lo, float hi) { unsigned r; asm volatile("v_cvt_pk_bf16_f32 %0, %1, %2" : "=v"(r) : "v"(lo), "v"(hi)); return r; }

struct DenseOrder {
    static constexpr bool GATHER = false;
    int nM, nN, nwg, G, c, K; const char* A; const char* B;
    __device__ void init(const void* A_, const void* B_, int M, int N, int K_, int G_, int c_) { A = (const char*)A_; B = (const char*)B_; K = K_; nM = M / BM; nN = N / BM; nwg = nM * nN; G = G_; c = c_; }
    __device__ __forceinline__ bool next(int i, Unit& u) const {
        const long L = (long)i * G + c; if (L >= nwg) return false;
        int wgid = (int)L; { const int q = nwg / NXCD, r = nwg % NXCD, xcd = wgid % NXCD, off = wgid / NXCD; wgid = (xcd < r ? xcd * (q + 1) : r * (q + 1) + (xcd - r) * q) + off; }
        const int nig = WGM * nN, gid = wgid / nig, fm = gid * WGM, gsz = (nM - fm) < WGM ? (nM - fm) : WGM;
        u.pm = fm + ((wgid % nig) % gsz); u.pn = (wgid % nig) / gsz; u.e = 0;
        u.A = A + (size_t)u.pm * BM * K * 2; u.B = B + (size_t)u.pn * BM * K * 2; return true;
    }
    __device__ __forceinline__ int arow(const Unit&, int row) const { return row; }
};

template <class Epi, class Sched, bool ALIGN_EPI>
__device__ __forceinline__ void gemm_phase(PG8_LAS unsigned char* lds, const int K, const Sched& S, const Epi& E) {
    int tid_ = threadIdx.x; asm volatile("" : "+v"(tid_));
    const int tid = tid_, wid = __builtin_amdgcn_readfirstlane(tid >> 6), lane = tid & 63, wr = wid >> 2, wc = wid & 3, fr = lane & 15, fq = lane >> 4;
    const int nt = K / BK;
    int sR[2], sC[2];
    unsigned voffB[2];
#pragma unroll
    for (int i = 0; i < 2; ++i) { stage_rc(tid * 16 + i * 8192, sR[i], sC[i]); const int Rb = Epi::PERM ? ((sR[i] & ~31) + perm32(sR[i] & 31)) : sR[i]; voffB[i] = (unsigned)(Rb * K + sC[i]) * 2u; }
    const size_t kstep = (size_t)(BK * 2);
    const size_t hstepB = (size_t)HALF * K * 2;
    const unsigned ldsw = (unsigned)wid * 1024u;
    const int aoff = lds_byte(wr * 64 + fr, fq * 8), boff = lds_byte(wc * 32 + fr, fq * 8);
#define PG8_SA(b, h) (((b) * 2 + (h)) * HTB)
#define PG8_SB(b, h) ((4 + (b) * 2 + (h)) * HTB)
#define PG8_STAGE(bufoff, gbase, voff) do { _Pragma("unroll") for (int _i = 0; _i < 2; ++_i) \
        __builtin_amdgcn_global_load_lds((const unsigned*)((const char*)(gbase) + (voff)[_i]), (PG8_LAS unsigned*)(lds + (bufoff) + ldsw + _i * 8192), 16, 0, 0); } while (0)
#define PG8_LDA(dst, b, h) do { _Pragma("unroll") for (int m = 0; m < 4; ++m) _Pragma("unroll") for (int k = 0; k < 2; ++k) dst[m][k] = *(const PG8_LAS bf16x8*)(lds + PG8_SA(b, h) + aoff + m * 2048 + k * 1024); } while (0)
#define PG8_LDB(dst, b, h) do { _Pragma("unroll") for (int n = 0; n < 2; ++n) _Pragma("unroll") for (int k = 0; k < 2; ++k) dst[n][k] = *(const PG8_LAS bf16x8*)(lds + PG8_SB(b, h) + boff + n * 2048 + k * 1024); } while (0)
#define PG8_MMA(ai, bj, At, Bt) do { __builtin_amdgcn_s_setprio(1); _Pragma("unroll") for (int m = 0; m < 4; ++m) _Pragma("unroll") for (int n = 0; n < 2; ++n) _Pragma("unroll") for (int k = 0; k < 2; ++k) \
        acc[ai][bj][m][n] = __builtin_amdgcn_mfma_f32_16x16x32_bf16(Bt[n][k], At[m][k], acc[ai][bj][m][n], 0, 0, 0); __builtin_amdgcn_s_setprio(0); } while (0)
#define PG8_WAIT_V(n) asm volatile("s_waitcnt vmcnt(" #n ")" ::: "memory")
#define PG8_WAIT_L(n) asm volatile("s_waitcnt lgkmcnt(" #n ")" ::: "memory")
#define PG8_BAR __builtin_amdgcn_s_barrier()
#define PG8_SCHED __builtin_amdgcn_sched_barrier(0)
#define PG8_VOFFA(dst, u) do { _Pragma("unroll") for (int _h = 0; _h < 2; ++_h) _Pragma("unroll") for (int _i = 0; _i < 2; ++_i) { \
        const int _row = 128 * _h + sR[_i]; const unsigned _rg = Sched::GATHER ? (unsigned)S.arow(u, _row) : (unsigned)_row; \
        dst[_h][_i] = (_rg * (unsigned)K + (unsigned)sC[_i]) * 2u; } } while (0)
    Unit cur, nxt; int ui = 0;
    if (!S.next(0, cur)) return;
    f32x4 acc[2][2][4][2];
#pragma unroll
    for (int a = 0; a < 2; ++a)
#pragma unroll
        for (int b = 0; b < 2; ++b)
#pragma unroll
            for (int m = 0; m < 4; ++m)
#pragma unroll
                for (int n = 0; n < 2; ++n) acc[a][b][m][n] = (f32x4){0.f, 0.f, 0.f, 0.f};
    bf16x8 At[4][2], B0[2][2], B1[2][2];
    unsigned vo[2][2], nvo[2][2];
    PG8_VOFFA(vo, cur);
    const char* cA = cur.A; const char* cB = cur.B;
    PG8_STAGE(PG8_SB(0, 0), cB, voffB); PG8_STAGE(PG8_SB(0, 1), cB + hstepB, voffB); PG8_STAGE(PG8_SA(0, 0), cA, vo[0]); PG8_STAGE(PG8_SA(0, 1), cA, vo[1]);
    if (wr == 1) PG8_BAR;
    PG8_WAIT_V(2); PG8_BAR;
    PG8_STAGE(PG8_SB(1, 0), cB + kstep, voffB); PG8_STAGE(PG8_SA(1, 0), cA + kstep, vo[0]); PG8_STAGE(PG8_SB(1, 1), cB + hstepB + kstep, voffB);
    PG8_WAIT_V(6); PG8_BAR;
    for (;;) {
        const bool has_next = S.next(ui + 1, nxt);
        const char* nA = has_next ? nxt.A : cA; const char* nB = has_next ? nxt.B : cB;
        if constexpr (Sched::GATHER) { if (has_next) { PG8_VOFFA(nvo, nxt); } else {
#pragma unroll
            for (int h = 0; h < 2; ++h)
#pragma unroll
                for (int i = 0; i < 2; ++i) nvo[h][i] = vo[h][i]; } }
#pragma unroll 1
        for (int t = 0; t < nt; t += 2) {
            const bool last = (t == nt - 2);
            const char* a1 = cA + (size_t)(t + 1) * kstep;
            const char* a2 = last ? nA : cA + (size_t)(t + 2) * kstep; const char* b2 = last ? nB : cB + (size_t)(t + 2) * kstep;
            const char* a3 = a2 + kstep; const char* b3 = b2 + kstep;
            unsigned va2[2][2];
#pragma unroll
            for (int h = 0; h < 2; ++h)
#pragma unroll
                for (int i = 0; i < 2; ++i) va2[h][i] = (Sched::GATHER && last) ? nvo[h][i] : vo[h][i];
            PG8_LDB(B0, 0, 0); PG8_LDB(B1, 0, 1); PG8_SCHED; PG8_LDA(At, 0, 0); PG8_STAGE(PG8_SA(1, 1), a1, vo[1]);
            PG8_WAIT_V(8); PG8_WAIT_L(0); PG8_BAR; PG8_MMA(0, 0, At, B0); PG8_MMA(0, 1, At, B1); PG8_BAR; PG8_SCHED;
            PG8_LDA(At, 0, 1); PG8_STAGE(PG8_SB(0, 0), b2, voffB); PG8_STAGE(PG8_SB(0, 1), b2 + hstepB, voffB); PG8_STAGE(PG8_SA(0, 0), a2, va2[0]);
            PG8_WAIT_V(8); PG8_WAIT_L(0); PG8_BAR; PG8_MMA(1, 0, At, B0); PG8_MMA(1, 1, At, B1); PG8_BAR; PG8_SCHED;
            PG8_LDB(B0, 1, 0); PG8_LDB(B1, 1, 1); PG8_SCHED; PG8_LDA(At, 1, 0); PG8_STAGE(PG8_SA(0, 1), a2, va2[1]);
            PG8_WAIT_V(8); PG8_WAIT_L(0); PG8_BAR; PG8_MMA(0, 0, At, B0); PG8_MMA(0, 1, At, B1); PG8_BAR; PG8_SCHED;
            PG8_LDA(At, 1, 1); PG8_STAGE(PG8_SB(1, 0), b3, voffB); PG8_STAGE(PG8_SB(1, 1), b3 + hstepB, voffB); PG8_STAGE(PG8_SA(1, 0), a3, va2[0]);
            PG8_WAIT_V(8); PG8_WAIT_L(0); PG8_BAR; PG8_MMA(1, 0, At, B0); PG8_MMA(1, 1, At, B1); PG8_BAR; PG8_SCHED;
        }
        if constexpr (ALIGN_EPI) { if (wr == 0) PG8_BAR; }
        E(acc, cur, wr, wc, fr, fq);
        if (!has_next) break;
#pragma unroll
        for (int a = 0; a < 2; ++a)
#pragma unroll
            for (int b = 0; b < 2; ++b)
#pragma unroll
                for (int m = 0; m < 4; ++m)
#pragma unroll
                    for (int n = 0; n < 2; ++n) acc[a][b][m][n] = (f32x4){0.f, 0.f, 0.f, 0.f};
        cur = nxt; cA = nA; cB = nB; ++ui;
        if constexpr (Sched::GATHER) {
#pragma unroll
        for (int h = 0; h < 2; ++h)
#pragma unroll
            for (int i = 0; i < 2; ++i) vo[h][i] = nvo[h][i]; }
        if constexpr (ALIGN_EPI) { if (wr == 1) PG8_BAR; }
    }
    PG8_WAIT_V(0);
    if constexpr (!ALIGN_EPI) { if (wr == 0) PG8_BAR; }
    PG8_BAR;
#undef PG8_SA
#undef PG8_SB
#undef PG8_STAGE
#undef PG8_LDA
#undef PG8_LDB
#undef PG8_MMA
#undef PG8_WAIT_V
#undef PG8_WAIT_L
#undef PG8_BAR
#undef PG8_SCHED
#undef PG8_VOFFA
}
}
namespace att {
typedef unsigned short bf16_t;
using bf16x8 = __attribute__((ext_vector_type(8))) short;
using s16x4  = __attribute__((ext_vector_type(4))) short;
using f32x16 = __attribute__((ext_vector_type(16))) float;
using f32x4  = __attribute__((ext_vector_type(4))) float;
using u32x4  = __attribute__((ext_vector_type(4))) unsigned;
constexpr int NW = 8, QBLK = 32, KVBLK = 64;
constexpr float NEGV = -1e30f, MINIT = -1e29f, THR = 8.f;
#define ASBAR() __builtin_amdgcn_sched_barrier(0)
__device__ __forceinline__ int crow(int r, int hi) { return (r & 3) + 8 * (r >> 2) + 4 * hi; }
__device__ __forceinline__ unsigned cvtpk(float lo, float hi) { unsigned r; asm volatile("v_cvt_pk_bf16_f32 %0, %1, %2" : "=v"(r) : "v"(lo), "v"(hi)); return r; }
__device__ __forceinline__ int kswz(int row, int c8) { return row * 128 + ((c8 ^ ((row >> 1) & 7)) << 4); }
template <int NCB> __device__ __forceinline__ int v_st(int k, int c) { const int kk = (k & ~0xC) | ((k & 4) << 1) | ((k & 8) >> 1); return ((kk >> 3) * NCB + (c >> 5)) * 512 + ((kk & 7) * 32 + (c & 31)) * 2; }
__device__ __forceinline__ int v_rd_base(int lane) { return ((lane & 3) << 3) | (((lane >> 2) & 3) << 6) | (((lane >> 4) & 1) << 5) | (((lane >> 5) & 1) << 8); }
template <int OFF> __device__ __forceinline__ s16x4 tr_read(int vb) { s16x4 r; asm volatile("ds_read_b64_tr_b16 %0, %1 offset:%2" : "=&v"(r) : "v"(vb), "i"(OFF) : "memory"); return r; }

__device__ __forceinline__ void partialSM(f32x16& p0, f32x16& p1, float& m_reg, float& alpha) {
  float pmax = p0[0];
#pragma unroll
  for (int r = 1; r < 16; ++r) pmax = fmaxf(pmax, p0[r]);
#pragma unroll
  for (int r = 0; r < 16; ++r) pmax = fmaxf(pmax, p1[r]);
  { auto rr = __builtin_amdgcn_permlane32_swap(__float_as_uint(pmax), __float_as_uint(pmax), false, false);
    pmax = fmaxf(__uint_as_float(rr[0]), __uint_as_float(rr[1])); }
  float mn;
  if (__builtin_expect(__all(pmax - m_reg <= THR), 1)) { mn = m_reg; alpha = 1.f; }
  else { mn = fmaxf(m_reg, pmax); alpha = __builtin_amdgcn_exp2f(m_reg - mn); m_reg = mn; }
#pragma unroll
  for (int r = 0; r < 16; ++r) p0[r] = p0[r] - mn;
#pragma unroll
  for (int r = 0; r < 16; ++r) p1[r] = p1[r] - mn;
#pragma unroll
  for (int r = 0; r < 16; ++r) p0[r] = __builtin_amdgcn_exp2f(p0[r]);
}
__device__ __forceinline__ void finishSM(f32x16& p0, f32x16& p1, float alpha, float& l_reg, bf16x8& pa0, bf16x8& pa1, bf16x8& pa2, bf16x8& pa3) {
#pragma unroll
  for (int r = 0; r < 16; ++r) p1[r] = __builtin_amdgcn_exp2f(p1[r]);
  float ps = 0;
#pragma unroll
  for (int r = 0; r < 16; ++r) ps += p0[r];
#pragma unroll
  for (int r = 0; r < 16; ++r) ps += p1[r];
  { auto rr = __builtin_amdgcn_permlane32_swap(__float_as_uint(ps), __float_as_uint(ps), false, false);
    ps = __uint_as_float(rr[0]) + __uint_as_float(rr[1]); }
  l_reg = l_reg * alpha + ps;
#define PK4(P, BASE, OUT) do { unsigned a0 = cvtpk(P[BASE + 0], P[BASE + 1]), a1 = cvtpk(P[BASE + 2], P[BASE + 3]);   \
    unsigned b0 = cvtpk(P[BASE + 4], P[BASE + 5]), b1 = cvtpk(P[BASE + 6], P[BASE + 7]);                              \
    auto r0 = __builtin_amdgcn_permlane32_swap(a0, b0, false, false); auto r1 = __builtin_amdgcn_permlane32_swap(a1, b1, false, false); \
    u32x4 w = {r0[0], r1[0], r0[1], r1[1]}; OUT = *reinterpret_cast<bf16x8*>(&w); } while (0)
  PK4(p0, 0, pa0); PK4(p0, 8, pa1); PK4(p1, 0, pa2); PK4(p1, 8, pa3);
#undef PK4
}
__device__ __forceinline__ void qkt(f32x16& p0, f32x16& p1, const char* Ks, const bf16x8 (&qr)[4], int r32, int hi) {
  p0 = f32x16{}; p1 = f32x16{};
#pragma unroll
  for (int d0 = 0; d0 < 4; ++d0) { const int c8 = d0 * 2 + hi;
    bf16x8 b0 = *reinterpret_cast<const bf16x8*>(Ks + kswz(r32, c8));
    bf16x8 b1 = *reinterpret_cast<const bf16x8*>(Ks + kswz(32 + r32, c8));
    p0 = __builtin_amdgcn_mfma_f32_32x32x16_bf16(b0, qr[d0], p0, 0, 0, 0);
    p1 = __builtin_amdgcn_mfma_f32_32x32x16_bf16(b1, qr[d0], p1, 0, 0, 0); }
}
template <int NCB, int D0> __device__ __forceinline__ void pv_one(f32x16& od, int vb, bf16x8 pa0, bf16x8 pa1, bf16x8 pa2, bf16x8 pa3) {
#define VRO(ks, half) (D0 * 512 + (ks) * (NCB * 1024) + (half) * (NCB * 512))
  const s16x4 l0 = tr_read<VRO(0, 0)>(vb), h0 = tr_read<VRO(0, 1)>(vb), l1 = tr_read<VRO(1, 0)>(vb), h1 = tr_read<VRO(1, 1)>(vb);
  const s16x4 l2 = tr_read<VRO(2, 0)>(vb), h2 = tr_read<VRO(2, 1)>(vb), l3 = tr_read<VRO(3, 0)>(vb), h3 = tr_read<VRO(3, 1)>(vb);
#undef VRO
  asm volatile("s_waitcnt lgkmcnt(0)" ::: "memory"); ASBAR();
#define PK(L, H) (bf16x8){L[0], L[1], L[2], L[3], H[0], H[1], H[2], H[3]}
  od = __builtin_amdgcn_mfma_f32_32x32x16_bf16(pa0, PK(l0, h0), od, 0, 0, 0);
  od = __builtin_amdgcn_mfma_f32_32x32x16_bf16(pa1, PK(l1, h1), od, 0, 0, 0);
  od = __builtin_amdgcn_mfma_f32_32x32x16_bf16(pa2, PK(l2, h2), od, 0, 0, 0);
  od = __builtin_amdgcn_mfma_f32_32x32x16_bf16(pa3, PK(l3, h3), od, 0, 0, 0);
#undef PK
}
template <int NCB> __device__ __forceinline__ void pv_all(f32x16 (&o)[NCB], int vb, bf16x8 pa0, bf16x8 pa1, bf16x8 pa2, bf16x8 pa3) {
  pv_one<NCB, 0>(o[0], vb, pa0, pa1, pa2, pa3); pv_one<NCB, 1>(o[1], vb, pa0, pa1, pa2, pa3);
  if constexpr (NCB == 4) { pv_one<NCB, 2>(o[2], vb, pa0, pa1, pa2, pa3); pv_one<NCB, 3>(o[3], vb, pa0, pa1, pa2, pa3); }
}

constexpr int L_V = 0, L_K = 49152, L_WS = 73728, L_BIAS = 75776, L_STG = 0, ATT_LDS = 77824;
__device__ __forceinline__ int swap23(int k) { return (k & ~0xC) | ((k & 4) << 1) | ((k & 8) >> 1); }

template <int DV, class Msk>
__device__ __forceinline__ void attn_tiles(f32x16 (&o)[DV / 32], float& m_reg, float& l_reg, const bf16x8 (&qr)[4],
                                           const bf16_t* __restrict__ Kh, const bf16_t* __restrict__ Vh, const int ld, const int NT, const Msk& msk, char* lds, const int tid) {
  constexpr int NCB = DV / 32, SHM_V = KVBLK * DV * 2, SHM_K = KVBLK * 64 * 2, NVI = DV / 64;
  const int wid = __builtin_amdgcn_readfirstlane(tid >> 6), lane = tid & 63, r32 = lane & 31, hi = lane >> 5;
  char* V_lds = lds + L_V; char* K_lds = lds + L_K;
  float* ws = (float*)(lds + L_WS) + wid * 64; float* al_l = ws + 32;
  unsigned koff, voff[NVI];
  { const int row = 8 * wid + (lane >> 3), c8 = (lane & 7) ^ ((row >> 1) & 7); koff = (unsigned)(row * ld + c8 * 8) * 2u; }
#pragma unroll
  for (int i = 0; i < NVI; ++i) { const int p = (NVI * wid + i) * 64 + lane, sidx = p >> 5, q = p & 31; const int kk = (sidx / NCB) * 8 + (q >> 2), k = swap23(kk), c = (sidx % NCB) * 32 + (q & 3) * 8;
      voff[i] = (unsigned)(k * ld + c) * 2u; }
  const char* Kb = (const char*)Kh; const char* Vb = (const char*)Vh; const size_t tstep = (size_t)KVBLK * ld * 2;
  typedef __attribute__((address_space(3))) unsigned lds_u32;
  lds_u32* kdst = (lds_u32*)(__attribute__((address_space(3))) char*)(uintptr_t)(unsigned)(uintptr_t)(K_lds + wid * 1024);
  lds_u32* vdst = (lds_u32*)(__attribute__((address_space(3))) char*)(uintptr_t)(unsigned)(uintptr_t)(V_lds + NVI * wid * 1024);
#define DMA_K(t, sl) __builtin_amdgcn_global_load_lds((const unsigned*)(Kb + (size_t)(t) * tstep + koff), (lds_u32*)((__attribute__((address_space(3))) char*)kdst + (sl) * SHM_K), 16, 0, 0)
#define DMA_V(t, sl) do { _Pragma("unroll") for (int _i = 0; _i < NVI; ++_i) \
    __builtin_amdgcn_global_load_lds((const unsigned*)(Vb + (size_t)(t) * tstep + voff[_i]), (lds_u32*)((__attribute__((address_space(3))) char*)vdst + (sl) * SHM_V + _i * 1024), 16, 0, 0); } while (0)
#define WAITV(n) asm volatile("s_waitcnt vmcnt(" #n ")" ::: "memory")
#define ENDSTEP_STEADY() do { if constexpr (NVI == 2) WAITV(3); else WAITV(2); asm volatile("s_waitcnt lgkmcnt(0)" ::: "memory"); __builtin_amdgcn_s_barrier(); asm volatile("" ::: "memory"); } while (0)
#define ENDSTEP_DRAIN() do { WAITV(0); asm volatile("s_waitcnt lgkmcnt(0)" ::: "memory"); __builtin_amdgcn_s_barrier(); asm volatile("" ::: "memory"); } while (0)
#define RESC(a) do { if (__any((a) < 1.f)) { if (hi == 0) al_l[r32] = (a); asm volatile("s_waitcnt lgkmcnt(0)" ::: "memory"); \
    _Pragma("unroll") for (int d = 0; d < NCB; ++d) _Pragma("unroll") for (int r = 0; r < 16; ++r) o[d][r] *= al_l[crow(r, hi)]; } } while (0)
  const int vb0 = (int)(uintptr_t)V_lds + v_rd_base(lane);
  f32x16 pA0, pA1, pB0, pB1; float alA, alB; bf16x8 pa0, pa1, pa2, pa3;
  int sa = 0, sb = 1, sc = 2;
#define ROT() do { const int _t = sa; sa = sb; sb = sc; sc = _t; } while (0)
  DMA_K(0, 0); DMA_V(0, 0); DMA_K(1, 1);
  WAITV(1); __builtin_amdgcn_s_barrier(); asm volatile("" ::: "memory");
  DMA_K(2, 2); DMA_V(1, 1);
  qkt(pA0, pA1, K_lds, qr, r32, hi); msk(pA0, pA1, 0, r32, hi); partialSM(pA0, pA1, m_reg, alA);
  ENDSTEP_STEADY();
#define STEP(j, PC0, PC1, alC, PF0, PF1, alF) do { \
    if ((j) + 2 < NT) DMA_K((j) + 2, sa); if ((j) + 1 < NT) DMA_V((j) + 1, sc); \
    ASBAR(); qkt(PC0, PC1, K_lds + sb * SHM_K, qr, r32, hi); msk(PC0, PC1, (j), r32, hi); \
    finishSM(PF0, PF1, alF, l_reg, pa0, pa1, pa2, pa3); ASBAR(); \
    pv_all<NCB>(o, vb0 + sa * SHM_V, pa0, pa1, pa2, pa3); partialSM(PC0, PC1, m_reg, alC); \
    RESC(alC); \
    if ((j) + 2 < NT) ENDSTEP_STEADY(); else ENDSTEP_DRAIN(); \
    ROT(); } while (0)
  int j = 1;
  for (; j + 1 < NT; j += 2) {
    STEP(j, pB0, pB1, alB, pA0, pA1, alA);
    STEP(j + 1, pA0, pA1, alA, pB0, pB1, alB);
  }
  STEP(j, pB0, pB1, alB, pA0, pA1, alA);
  finishSM(pB0, pB1, alB, l_reg, pa0, pa1, pa2, pa3); ASBAR();
  pv_all<NCB>(o, vb0 + sa * SHM_V, pa0, pa1, pa2, pa3);
  asm volatile("s_waitcnt lgkmcnt(0)" ::: "memory");
#undef DMA_K
#undef DMA_V
#undef WAITV
#undef ENDSTEP_STEADY
#undef ENDSTEP_DRAIN
#undef RESC
#undef ROT
#undef STEP
}

template <int NCB> __device__ __forceinline__ void normalize_rows(f32x16 (&o)[NCB], float l_reg, char* lds, const int tid) {
  const int wid = tid >> 6, lane = tid & 63, r32 = lane & 31, hi = lane >> 5;
  float* ws = (float*)(lds + L_WS) + wid * 64;
  if (hi == 0) ws[r32] = l_reg; asm volatile("s_waitcnt lgkmcnt(0)" ::: "memory");
#pragma unroll
  for (int r = 0; r < 16; ++r) { const float rl = __builtin_amdgcn_rcpf(ws[crow(r, hi)]);
#pragma unroll
    for (int d = 0; d < NCB; ++d) o[d][r] *= rl; }
  asm volatile("s_waitcnt lgkmcnt(0)" ::: "memory");
}
template <int DV> __device__ __forceinline__ void store_rows(const f32x16 (&o)[DV / 32], bf16_t* out, const long ld, char* lds, const int tid) {
  constexpr int NCB = DV / 32;
  const int wid = tid >> 6, lane = tid & 63, r32 = lane & 31, hi = lane >> 5;
  bf16_t* stg = (bf16_t*)(lds + L_STG) + wid * (32 * 128);
#pragma unroll
  for (int r = 0; r < 16; ++r) { const int orow = crow(r, hi);
#pragma unroll
    for (int d0 = 0; d0 < NCB; ++d0) { const unsigned u = __float_as_uint(o[d0][r]); stg[orow * DV + d0 * 32 + r32] = (bf16_t)((u + 0x7fffu + ((u >> 16) & 1u)) >> 16); } }
  asm volatile("s_waitcnt lgkmcnt(0)" ::: "memory");
  constexpr int CPR = DV / 8, RPI = 64 / CPR;
#pragma unroll
  for (int i = 0; i < 32 / RPI; ++i) { const int row = i * RPI + lane / CPR, ch = lane % CPR;
    const u32x4 v = *(const u32x4*)(stg + row * DV + ch * 8); *(u32x4*)(out + (long)row * ld + ch * 8) = v; }
  asm volatile("s_waitcnt lgkmcnt(0)" ::: "memory");
}
struct NoMask { __device__ __forceinline__ void operator()(f32x16&, f32x16&, int, int, int) const {} };
#undef ASBAR
}
#ifndef MK_N_LAUNCHES
#define MK_N_LAUNCHES 1
#endif
constexpr int NPH = 22;
constexpr int NWAVES = 8;
constexpr int BATCH = 4, SEQ = 8192, T = BATCH * SEQ, DM = 1024;
constexpr int NEXP = 256, TOPK = 8;
constexpr int NSLOT_MAX = 327424;
constexpr int NTILE_E = NSLOT_MAX / 256;
constexpr int HROWS = NSLOT_MAX + T;
constexpr float LN_EPS = 1e-5f;
constexpr float DN_ALPHA = 1.4142135623730951f;
constexpr float LOG2E = 1.4426950408889634f;
constexpr float C2 = 0.125f * 1.4426950408889634f;
constexpr float LAMBDA_INIT0 = 0.2f;

constexpr size_t MiB = 1u << 20;
constexpr size_t WS_CTL = 0, CTL_ZERO_BYTES = 1 * MiB;
constexpr size_t WS_ROPE = 1 * MiB;
constexpr size_t WS_SEL_E = 3 * MiB, WS_SEL_G = 4 * MiB, WS_SEL_POS = 5 * MiB;
constexpr size_t WS_GTOK = 6 * MiB, WS_DEST = 8 * MiB;
constexpr size_t WS_BCNT = 9 * MiB + 512 * 1024;
constexpr size_t WS_O1S = 10 * MiB;
constexpr size_t WS_W0IN = 42 * MiB, WS_W0OUT = 48 * MiB, WS_R0 = 50 * MiB, WS_W1IN = 51 * MiB, WS_W1OUT = 54 * MiB, WS_R1 = 56 * MiB;
constexpr size_t WS_EGU = 57 * MiB;
constexpr size_t WS_ED = 314 * MiB;
constexpr size_t WS_X1 = 443 * MiB;
constexpr size_t WS_X1B = 571 * MiB;
constexpr size_t WS_H = 635 * MiB;
constexpr size_t WS_R = 811 * MiB;
constexpr size_t WS_XB = WS_R, WS_HCAT = WS_R + 64 * MiB, WS_ATT = WS_R + 256 * MiB, WS_Y = WS_R + 320 * MiB, WS_YS = WS_R;
constexpr size_t WS_EGU1 = 1387 * MiB;
constexpr size_t WS_END = 1644 * MiB;
static_assert(WS_EGU + (size_t)257 * 512 * 1024 * 2 <= WS_ED && WS_ED + (size_t)257 * 1024 * 256 * 2 <= WS_X1, "ws map: experts");
static_assert(WS_H + (size_t)HROWS * 256 * 2 <= WS_R && WS_YS + (size_t)(T * 9) * 1024 * 2 <= WS_END, "ws map: H / YS");
constexpr int CW_TMO = 0, CW_BAR = 4096, CW_CNT = 8192;

constexpr int RING_OFF = 0, RING_BYTES = 131072;
constexpr int LDSCTL_OFF = RING_BYTES;
constexpr int L_PADSTART = LDSCTL_OFF + 512;
constexpr int L_TILE_E = L_PADSTART + 1536;
constexpr int L_SCAN = L_TILE_E + 3072;
constexpr int L_LCNT = L_SCAN + 1024;
constexpr int L_SMALL = L_LCNT + 1024;
constexpr int LDS_BYTES = 147456;
static_assert(L_SMALL + 256 <= LDS_BYTES, "LDS map");

#define GAS __attribute__((address_space(1)))
#define CAS __attribute__((address_space(4)))
#define LAS __attribute__((address_space(3)))
typedef unsigned short bf16;
typedef unsigned v4u __attribute__((ext_vector_type(4)));
typedef float f32x4 __attribute__((ext_vector_type(4)));
typedef short bf16x8 __attribute__((ext_vector_type(8)));
#define LDS_WAIT() asm volatile("s_waitcnt lgkmcnt(0)" ::: "memory")
#define VM_WAIT() asm volatile("s_waitcnt vmcnt(0)" ::: "memory")
__device__ __forceinline__ unsigned f2bf(float f) { unsigned u = __builtin_bit_cast(unsigned, f); return (u + 0x7fffu + ((u >> 16) & 1u)) >> 16; }
__device__ __forceinline__ unsigned pk2(float lo, float hi) { return f2bf(lo) | (f2bf(hi) << 16); }
__device__ __forceinline__ float bf_lo(unsigned w) { return __builtin_bit_cast(float, w << 16); }
__device__ __forceinline__ float bf_hi(unsigned w) { return __builtin_bit_cast(float, w & 0xffff0000u); }

#define XB_TMO      128
#define XB_XCNT(j)  (256  + 64 * (j))
#define XB_XSUB(j)  (1280 + 64 * (j))
#define XB_XGEN(j)  (2304 + 64 * (j))
#define XB_TOP      3328
#define XB_TOPGEN   3392
#define XCD_BAR_WORDS 3456
#define XB_SPIN_CAP (1u << 20)
__device__ __forceinline__ unsigned xb_ld(unsigned* p)              { return __hip_atomic_load(p, __ATOMIC_RELAXED, __HIP_MEMORY_SCOPE_AGENT); }
__device__ __forceinline__ unsigned xb_add(unsigned* p, unsigned v) { return __hip_atomic_fetch_add(p, v, __ATOMIC_RELAXED, __HIP_MEMORY_SCOPE_AGENT); }
__device__ __forceinline__ unsigned xb_xcc_id() { return (unsigned)__builtin_amdgcn_s_getreg((3 << 11) | 20) & 0xFu; }
#define XB_SPIN(cond, bar) do { unsigned _sp = 0; while (cond) { __builtin_amdgcn_s_sleep(1); \
    if ((++_sp & 255u) == 0u) { if (xb_ld(&(bar)[XB_TMO])) break; if (_sp > XB_SPIN_CAP) { atomicAdd(&(bar)[XB_TMO], 1u); break; } } } } while (0)
struct XcdBarrier { unsigned* bar; unsigned x; volatile LAS unsigned* st; };
__device__ __forceinline__ XcdBarrier xcd_barrier_post(unsigned* bar, volatile LAS unsigned* st) {
    XcdBarrier b; b.bar = bar; b.x = xb_xcc_id(); b.st = st;
    if (threadIdx.x == 0) (void)xb_add(&bar[XB_XCNT(b.x)], 1u);
    return b;
}
__device__ __forceinline__ void xcd_barrier_complete(unsigned* bar, unsigned x, unsigned& nloc, unsigned& nx) {
    const unsigned G = gridDim.x * gridDim.y * gridDim.z;
    unsigned sum, cnt, mine, sp = 0u;
    for (;;) {
        sum = 0u; cnt = 0u; mine = 0u;
#pragma unroll
        for (unsigned j = 0; j < 16; ++j) { const unsigned c = xb_ld(&bar[XB_XCNT(j)]); sum += c; cnt += (c > 0u) ? 1u : 0u; mine = (j == x) ? c : mine; }
        if (sum == G) break;
        __builtin_amdgcn_s_sleep(1);
        if ((++sp & 255u) == 0u) { if (xb_ld(&bar[XB_TMO])) break; if (sp > XB_SPIN_CAP) { atomicAdd(&bar[XB_TMO], 1u); break; } }
    }
    nloc = mine > 0u ? mine : 1u; nx = cnt > 0u ? cnt : 1u;
}
__device__ __forceinline__ void xcd_barrier(const XcdBarrier& b) {
    asm volatile("s_waitcnt vmcnt(0)" ::: "memory");
    __syncthreads();
    if (threadIdx.x == 0) {
        unsigned* bar = b.bar;
        __builtin_amdgcn_s_waitcnt(0);
        unsigned nloc = b.st[0], nx = b.st[1];
        if (nloc == 0u) { xcd_barrier_complete(bar, b.x, nloc, nx); b.st[0] = nloc; b.st[1] = nx; }
        const unsigned old = xb_add(&bar[XB_XSUB(b.x)], 1u);
        const unsigned gen = old / nloc;
        if (old + 1u == (gen + 1u) * nloc) {
            __builtin_amdgcn_fence(__ATOMIC_RELEASE, "agent");
            asm volatile("s_waitcnt vmcnt(0)" ::: "memory");
            const unsigned og = xb_add(&bar[XB_TOP], 1u);
            const unsigned tg = og / nx;
            if (og + 1u == (tg + 1u) * nx) xb_add(&bar[XB_TOPGEN], 1u);
            else XB_SPIN(xb_ld(&bar[XB_TOPGEN]) == tg, bar);
            __builtin_amdgcn_fence(__ATOMIC_ACQUIRE, "agent");
            xb_add(&bar[XB_XGEN(b.x)], 1u);
            asm volatile("s_waitcnt vmcnt(0)" ::: "memory");
        } else {
            XB_SPIN(xb_ld(&bar[XB_XGEN(b.x)]) == gen, bar);
            __builtin_amdgcn_fence(__ATOMIC_ACQUIRE, "agent");
            asm volatile("s_waitcnt vmcnt(0)" ::: "memory");
        }
    }
    __syncthreads();
}

struct Args { const float* in[36]; float* out; unsigned char* ws; int ph_lo, ph_hi; };

__device__ __forceinline__ int launder_v(int x) { asm volatile("" : "+v"(x)); return x; }
__device__ __forceinline__ const CAS Args* launder_ka(const CAS Args* p) { asm volatile("" : "+s"(p)); return p; }

struct Frame {
    LAS unsigned char* lds; char* ldsg;
    unsigned* ctl;
    unsigned char* ws;
    int tid, lane, wave, vcu, G;
    int gw, NGW, gt, NGT;
};

__device__ __forceinline__ float wave_sum(float v) {
#pragma unroll
    for (int o = 1; o < 64; o <<= 1) v += __shfl_xor(v, o);
    return v;
}

__device__ __forceinline__ void transpose_item(const float* W, int Nsrc, int K, int k0, int srccol, bf16* WTrow0, LAS float* scr, int lane) {
    float tv[32];
#pragma unroll
    for (int i = 0; i < 32; ++i) { const int kk = 2 * i + (lane >> 5); tv[i] = W[(size_t)(k0 + kk) * Nsrc + srccol]; }
#pragma unroll
    for (int i = 0; i < 32; ++i) { const int kk = 2 * i + (lane >> 5); scr[kk * 33 + (lane & 31)] = tv[i]; }
    LDS_WAIT(); asm volatile("" ::: "memory");
    const int c = lane & 7;
#pragma unroll
    for (int j = 0; j < 4; ++j) { const int n = (lane >> 3) + 8 * j; const LAS float* s = scr + (8 * c) * 33 + n;
        v4u o; o.x = pk2(s[0 * 33], s[1 * 33]); o.y = pk2(s[2 * 33], s[3 * 33]); o.z = pk2(s[4 * 33], s[5 * 33]); o.w = pk2(s[6 * 33], s[7 * 33]);
        *(v4u*)(WTrow0 + (size_t)n * K + k0 + 8 * c) = o; }
    LDS_WAIT(); asm volatile("" ::: "memory");
}
__device__ __forceinline__ void conv_dense_item(const float* W, int K, int N, bf16* WT, int r, int plo, int phi, LAS float* scr, int lane) {
    const int nblk = N / 32, kb = r / nblk, nb = r % nblk, n = nb * 32 + (lane & 31);
    int src = n; if (n >= plo && n < phi) { const int j = n & 63; src = (n & ~63) + (j >> 1) + 32 * (j & 1); }
    transpose_item(W, N, K, kb * 64, src, WT + (size_t)nb * 32 * K, scr, lane);
}
__device__ __forceinline__ void conv_expert_item(const float* Wg, const float* Wu, const float* Wd, bf16* egu, bf16* ed, int q, LAS float* scr, int lane) {
    if (q < 256) { const int kb = q >> 4, nb = q & 15, n0 = nb * 32, pn = n0 >> 8, half = (n0 >> 7) & 1, j0 = n0 & 127;
        transpose_item(half ? Wu : Wg, 256, 1024, kb * 64, 128 * pn + j0 + (lane & 31), egu + (size_t)n0 * 1024, scr, lane); }
    else { const int qq = q - 256, kb = qq >> 5, nb = qq & 31;
        transpose_item(Wd, 1024, 256, kb * 64, nb * 32 + (lane & 31), ed + (size_t)nb * 32 * 256, scr, lane); }
}
__device__ __forceinline__ void conv_egu(Frame& F, const float* g, const float* u, const float* sg, const float* su, bf16* EGU) {
    LAS float* scr = (LAS float*)(F.lds + RING_OFF + F.wave * 16384);
    for (int it = F.gw; it < 257 * 256; it += F.NGW) {
        const int e = it >> 8, q = it & 255;
        const float* Wg = e < 256 ? g + (size_t)e * 1024 * 256 : sg; const float* Wu = e < 256 ? u + (size_t)e * 1024 * 256 : su;
        conv_expert_item(Wg, Wu, nullptr, EGU + (size_t)e * 512 * 1024, nullptr, q, scr, F.lane);
    }
}
__device__ __forceinline__ void conv_ed(Frame& F, const float* d, const float* sd, bf16* ED) {
    LAS float* scr = (LAS float*)(F.lds + RING_OFF + F.wave * 16384);
    for (int it = F.gw; it < 257 * 128; it += F.NGW) {
        const int e = it >> 7, q = it & 127;
        const float* Wd = e < 256 ? d + (size_t)e * 256 * 1024 : sd;
        conv_expert_item(nullptr, nullptr, Wd, nullptr, ED + (size_t)e * 1024 * 256, 256 + q, scr, F.lane);
    }
}
__device__ __forceinline__ void build_tiles_cnt(Frame& F, const int cnt) {
    LAS int* sc = (LAS int*)(F.lds + L_SCAN); LAS int* ps = (LAS int*)(F.lds + L_PADSTART); LAS unsigned short* te = (LAS unsigned short*)(F.lds + L_TILE_E);
    int p = 0;
    if (F.tid < 256) { p = (cnt + 255) & ~255; sc[F.tid] = p; }
    __syncthreads();
    for (int off = 1; off < 256; off <<= 1) { int v = 0; if (F.tid < 256 && F.tid >= off) v = sc[F.tid - off]; __syncthreads(); if (F.tid < 256) sc[F.tid] += v; __syncthreads(); }
    if (F.tid < 256) { const int incl = sc[F.tid], start = incl - p; ps[F.tid] = start; if (F.tid == 255) ps[256] = incl;
        for (int r = start >> 8; r < (incl >> 8); ++r) te[r] = (unsigned short)F.tid; }
    __syncthreads();
}
__device__ __forceinline__ void build_tiles(Frame& F, const unsigned* counts) { build_tiles_cnt(F, F.tid < 256 ? (int)counts[F.tid] : 0); }
using pg8::Unit;
struct EpiProj {
    static constexpr bool PERM = true;
    bf16* O; int ldc; unsigned ropemask, scalemask; const float* rope;
    __device__ __forceinline__ void operator()(const f32x4 (&acc)[2][2][4][2], const Unit& u, int wr, int wc, int fr, int fq) const {
        const int row0 = u.pm * 256 + wr * 64 + fr, col0 = u.pn * 256 + wc * 32 + 8 * fq;
        const bool dorope = (ropemask >> u.pn) & 1u; const float sc = ((scalemask >> u.pn) & 1u) ? C2 : 1.f;
        const int i0 = 16 * (wc & 1) + 4 * fq;
#pragma unroll
        for (int ai = 0; ai < 2; ++ai)
#pragma unroll
            for (int m = 0; m < 4; ++m) { const int row = row0 + ai * 128 + m * 16;
                f32x4 cs0 = {1.f, 0.f, 1.f, 0.f}, cs1 = {1.f, 0.f, 1.f, 0.f};
                if (dorope) { const f32x4* tp = (const f32x4*)(rope + ((size_t)(row & (SEQ - 1)) * 32 + i0) * 2); cs0 = tp[0]; cs1 = tp[1]; }
                bf16* rowp = O + (size_t)row * ldc + col0;
#pragma unroll
                for (int bj = 0; bj < 2; ++bj) { const f32x4 a = acc[ai][bj][m][0], b = acc[ai][bj][m][1]; f32x4 v0, v1;
                    v0[0] = a[0] * cs0[0] - a[1] * cs0[1]; v0[1] = a[1] * cs0[0] + a[0] * cs0[1]; v0[2] = a[2] * cs0[2] - a[3] * cs0[3]; v0[3] = a[3] * cs0[2] + a[2] * cs0[3];
                    v1[0] = b[0] * cs1[0] - b[1] * cs1[1]; v1[1] = b[1] * cs1[0] + b[0] * cs1[1]; v1[2] = b[2] * cs1[2] - b[3] * cs1[3]; v1[3] = b[3] * cs1[2] + b[2] * cs1[3];
                    v0 = v0 * sc; v1 = v1 * sc;
                    v4u w; w.x = pg8::cvt_pk_bf16(v0[0], v0[1]); w.y = pg8::cvt_pk_bf16(v0[2], v0[3]); w.z = pg8::cvt_pk_bf16(v1[0], v1[1]); w.w = pg8::cvt_pk_bf16(v1[2], v1[3]);
                    *(v4u*)(rowp + bj * 128) = w; } }
    }
};
struct EpiRes {
    static constexpr bool PERM = false;
    float* C; int ldc; const float* res; float alpha;
    __device__ __forceinline__ void operator()(const f32x4 (&acc)[2][2][4][2], const Unit& u, int wr, int wc, int fr, int fq) const {
        const int row0 = u.pm * 256 + wr * 64 + fr, col0 = u.pn * 256 + wc * 32 + 4 * fq;
#pragma unroll
        for (int ai = 0; ai < 2; ++ai)
#pragma unroll
            for (int m = 0; m < 4; ++m) { const size_t ro = (size_t)(row0 + ai * 128 + m * 16) * ldc + col0;
#pragma unroll
                for (int bj = 0; bj < 2; ++bj)
#pragma unroll
                    for (int n = 0; n < 2; ++n) { f32x4 v = acc[ai][bj][m][n];
                        if (res) { const f32x4 r = *(const f32x4*)(res + ro + bj * 128 + n * 16); v = v + r * alpha; }
                        *(f32x4*)(C + ro + bj * 128 + n * 16) = v; } }
    }
};
struct EpiSwiGLU {
    static constexpr bool PERM = true;
    bf16* H;
    __device__ __forceinline__ void operator()(const f32x4 (&acc)[2][2][4][2], const Unit& u, int wr, int wc, int fr, int fq) const {
        const int row0 = u.pm * 256 + wr * 64 + fr, col0 = u.pn * 128 + wc * 32 + 8 * fq;
#pragma unroll
        for (int ai = 0; ai < 2; ++ai)
#pragma unroll
            for (int m = 0; m < 4; ++m) { bf16* rowp = H + (size_t)(row0 + ai * 128 + m * 16) * 256 + col0; float h[8];
#pragma unroll
                for (int n = 0; n < 2; ++n)
#pragma unroll
                    for (int x = 0; x < 4; ++x) { const float g = acc[ai][0][m][n][x], up = acc[ai][1][m][n][x];
                        h[n * 4 + x] = g * __builtin_amdgcn_rcpf(1.f + __builtin_amdgcn_exp2f(-g * LOG2E)) * up; }
                v4u w; w.x = pg8::cvt_pk_bf16(h[0], h[1]); w.y = pg8::cvt_pk_bf16(h[2], h[3]); w.z = pg8::cvt_pk_bf16(h[4], h[5]); w.w = pg8::cvt_pk_bf16(h[6], h[7]);
                *(v4u*)rowp = w; }
    }
};
struct EpiDown {
    static constexpr bool PERM = true;
    bf16* YS; const int* dest;
    __device__ __forceinline__ void operator()(const f32x4 (&acc)[2][2][4][2], const Unit& u, int wr, int wc, int fr, int fq) const {
        const int row0 = u.pm * 256 + wr * 64 + fr, col0 = u.pn * 256 + wc * 32 + 8 * fq;
        int dr[2][4];
#pragma unroll
        for (int ai = 0; ai < 2; ++ai)
#pragma unroll
            for (int m = 0; m < 4; ++m) dr[ai][m] = dest[row0 + ai * 128 + m * 16];
#pragma unroll
        for (int ai = 0; ai < 2; ++ai)
#pragma unroll
            for (int m = 0; m < 4; ++m) { if (dr[ai][m] >= 0) { bf16* rowp = YS + (size_t)dr[ai][m] * 1024 + col0;
#pragma unroll
                for (int bj = 0; bj < 2; ++bj) { const f32x4 v0 = acc[ai][bj][m][0], v1 = acc[ai][bj][m][1];
                    v4u w; w.x = pg8::cvt_pk_bf16(v0[0], v0[1]); w.y = pg8::cvt_pk_bf16(v0[2], v0[3]); w.z = pg8::cvt_pk_bf16(v1[0], v1[1]); w.w = pg8::cvt_pk_bf16(v1[2], v1[3]);
                    *(v4u*)(rowp + bj * 128) = w; } } }
    }
};
template <bool GATHER_, int SHIFT> struct MoeOrder {
    static constexpr bool GATHER = GATHER_;
    int R, G, c, K; const LAS unsigned short* te; const int* gtok; const char* A; const char* B; size_t bexp, btile;
    __device__ __forceinline__ bool next(int i, Unit& u) const {
        const int U = i * G + c, rp = U >> SHIFT; if (rp >= R + T / 256) return false;
        u.pn = U & ((1 << SHIFT) - 1); const bool sh = rp >= R; u.pm = sh ? NTILE_E + (rp - R) : rp; u.e = sh ? 256 : (int)te[sh ? 0 : rp];
        u.A = GATHER ? A : A + (size_t)u.pm * 256 * K * 2; u.B = B + (size_t)u.e * bexp + (size_t)u.pn * btile; return true;
    }
    __device__ __forceinline__ int arow(const Unit& u, int row) const { return gtok[u.pm * 256 + row]; }
};

struct NaMask {
    int r, c, kr0, rs, cs; const float* bias;
    __device__ __forceinline__ void operator()(att::f32x16& p0, att::f32x16& p1, int t, int r32, int hi) const {
        const int kr = kr0 + t; const bool rowok = (kr >= rs) && (kr < rs + 8);
        if (!rowok) {
#pragma unroll
            for (int q = 0; q < 16; ++q) { p0[q] = att::NEGV; p1[q] = att::NEGV; }
        } else { const float* bp = bias + (kr - r + 7) * 31 + 15 - c;
#pragma unroll
            for (int q = 0; q < 16; ++q) { const int k0 = att::crow(q, hi), k1 = k0 + 32;
                p0[q] = (k0 >= cs && k0 < cs + 16) ? p0[q] + bp[k0] : att::NEGV;
                p1[q] = (k1 >= cs && k1 < cs + 16) ? p1[q] + bp[k1] : att::NEGV; } }
    }
};
struct SwaMask {
    int qpos, k0;
    __device__ __forceinline__ void operator()(att::f32x16& p0, att::f32x16& p1, int t, int r32, int hi) const {
        const int base = k0 + 64 * t - qpos;
#pragma unroll
        for (int q = 0; q < 16; ++q) { const int d0 = base + att::crow(q, hi), d1 = d0 + 32;
            p0[q] = (d0 >= -128 && d0 <= 128) ? p0[q] : att::NEGV;
            p1[q] = (d1 >= -128 && d1 <= 128) ? p1[q] : att::NEGV; }
    }
};
__device__ __forceinline__ void na_unit(Frame& F, int b, int h, int rb, const bf16* hcat, bf16* attout, const float* rpb) {
    char* lds = F.ldsg + RING_OFF;
    const int tid = launder_v((int)threadIdx.x), lane = tid & 63, r32 = lane & 31, hi = lane >> 5, w = __builtin_amdgcn_readfirstlane(tid >> 6);
    const int r0 = rb * 4, r = r0 + (w >> 1), c = (w & 1) * 32 + r32;
    int kr0 = r0 - 4; kr0 = kr0 < 0 ? 0 : (kr0 > 116 ? 116 : kr0);
    float* bias = (float*)(lds + att::L_BIAS);
    __syncthreads();
    if (tid < 465) bias[tid] = rpb[h * 465 + tid] * LOG2E;
    const size_t tok = (size_t)b * SEQ + (size_t)r * 64 + c;
    const bf16* Ql = hcat + tok * 3072 + h * 64 + hi * 8;
    att::bf16x8 qr[4];
#pragma unroll
    for (int d0 = 0; d0 < 4; ++d0) qr[d0] = *reinterpret_cast<const att::bf16x8*>(Ql + d0 * 16);
    const bf16* Kh = hcat + ((size_t)b * SEQ + (size_t)kr0 * 64) * 3072 + 512 + h * 64;
    const bf16* Vh = Kh + 512;
    NaMask mk; mk.r = r; mk.c = c; mk.kr0 = kr0; { int rs = r - 4; mk.rs = rs < 0 ? 0 : (rs > 120 ? 120 : rs); int cs = c - 8; mk.cs = cs < 0 ? 0 : (cs > 48 ? 48 : cs); } mk.bias = bias;
    att::f32x16 o[2]; o[0] = att::f32x16{}; o[1] = att::f32x16{};
    float m_reg = att::MINIT, l_reg = 0.f;
    att::attn_tiles<64, NaMask>(o, m_reg, l_reg, qr, Kh, Vh, 3072, 12, mk, lds, tid);
    att::normalize_rows<2>(o, l_reg, lds, tid);
    const size_t tok0 = (size_t)b * SEQ + (size_t)r * 64 + (w & 1) * 32;
    __syncthreads();
    att::store_rows<64>(o, attout + tok0 * 1024 + h * 64, 1024, lds, tid);
}
__device__ __forceinline__ void swa_unit(Frame& F, int b, int hq, int qb, const bf16* hcat, bf16* attout, const float* sinks) {
    char* lds = F.ldsg + RING_OFF;
    const int tid = launder_v((int)threadIdx.x), lane = tid & 63, r32 = lane & 31, hi = lane >> 5, w = __builtin_amdgcn_readfirstlane(tid >> 6);
    const int q0 = qb * 256, qpos = q0 + w * 32 + r32;
    const int k0 = q0 - 128 < 0 ? 0 : q0 - 128, k1 = q0 + 384 > SEQ ? SEQ : q0 + 384, NT = (k1 - k0) / 64;
    __syncthreads();
    const size_t tok = (size_t)b * SEQ + qpos;
    const bf16* Ql = hcat + tok * 1536 + hq * 64 + hi * 8;
    att::bf16x8 qr[4];
#pragma unroll
    for (int d0 = 0; d0 < 4; ++d0) qr[d0] = *reinterpret_cast<const att::bf16x8*>(Ql + d0 * 16);
    const int kvh = hq >> 2;
    const bf16* Kh = hcat + ((size_t)b * SEQ + k0) * 1536 + 1024 + kvh * 64;
    const bf16* Vh = Kh + 256;
    SwaMask mk; mk.qpos = qpos; mk.k0 = k0;
    att::f32x16 o[2]; o[0] = att::f32x16{}; o[1] = att::f32x16{};
    float m_reg = sinks[hq] * LOG2E, l_reg = 1.f;
    att::attn_tiles<64, SwaMask>(o, m_reg, l_reg, qr, Kh, Vh, 1536, NT, mk, lds, tid);
    att::normalize_rows<2>(o, l_reg, lds, tid);
    const size_t tok0 = (size_t)b * SEQ + q0 + w * 32;
    __syncthreads();
    att::store_rows<64>(o, attout + tok0 * 1024 + hq * 64, 1024, lds, tid);
}
__device__ __forceinline__ void diff_unit(Frame& F, int b, int h, int qb, const bf16* hcat, bf16* attout, float lam, const float* subg, float* stash) {
    char* lds = F.ldsg + RING_OFF;
    const int tid = launder_v((int)threadIdx.x), lane = tid & 63, r32 = lane & 31, hi = lane >> 5, w = __builtin_amdgcn_readfirstlane(tid >> 6);
    const size_t tok = (size_t)b * SEQ + qb * 256 + w * 32 + r32;
    f32x4* st = (f32x4*)(stash + (size_t)blockIdx.x * 32768 + (size_t)tid * 64);
    for (int map = 0; map < 2; ++map) {
        __syncthreads();
        const bf16* Ql = hcat + tok * 3072 + 1536 + h * 128 + map * 64 + hi * 8;
        att::bf16x8 qr[4];
#pragma unroll
        for (int d0 = 0; d0 < 4; ++d0) qr[d0] = *reinterpret_cast<const att::bf16x8*>(Ql + d0 * 16);
        const bf16* Kh = hcat + (size_t)b * SEQ * 3072 + 2048 + h * 128 + map * 64;
        const bf16* Vh = hcat + (size_t)b * SEQ * 3072 + 2560 + h * 128;
        att::f32x16 o[4]; o[0] = att::f32x16{}; o[1] = att::f32x16{}; o[2] = att::f32x16{}; o[3] = att::f32x16{};
        float m_reg = att::MINIT, l_reg = 0.f;
        att::attn_tiles<128, att::NoMask>(o, m_reg, l_reg, qr, Kh, Vh, 3072, SEQ / 64, att::NoMask(), lds, tid);
        att::normalize_rows<4>(o, l_reg, lds, tid);
        if (map == 0) {
#pragma unroll
            for (int d = 0; d < 4; ++d)
#pragma unroll
                for (int q = 0; q < 4; ++q) st[d * 4 + q] = (f32x4){o[d][4 * q], o[d][4 * q + 1], o[d][4 * q + 2], o[d][4 * q + 3]};
        } else {
            float ss[16];
#pragma unroll
            for (int q = 0; q < 16; ++q) ss[q] = 0.f;
#pragma unroll
            for (int d = 0; d < 4; ++d)
#pragma unroll
                for (int q4 = 0; q4 < 4; ++q4) { const f32x4 s4 = st[d * 4 + q4];
#pragma unroll
                    for (int x = 0; x < 4; ++x) { const int q = 4 * q4 + x; const float v = s4[x] - lam * o[d][q]; o[d][q] = v; ss[q] += v * v; } }
#pragma unroll
            for (int q = 0; q < 16; ++q) { float s = ss[q]; s += __shfl_xor(s, 1); s += __shfl_xor(s, 2); s += __shfl_xor(s, 4); s += __shfl_xor(s, 8); s += __shfl_xor(s, 16);
                ss[q] = __builtin_amdgcn_rsqf(s * (1.f / 128.f) + LN_EPS) * (1.f - LAMBDA_INIT0); }
#pragma unroll
            for (int d = 0; d < 4; ++d) { const float g = subg[d * 32 + r32];
#pragma unroll
                for (int q = 0; q < 16; ++q) o[d][q] *= ss[q] * g; }
            const size_t tok0 = (size_t)b * SEQ + qb * 256 + w * 32;
            __syncthreads();
            att::store_rows<128>(o, attout + tok0 * 1024 + 512 + h * 128, 1024, lds, tid);
        }
    }
}

__device__ __forceinline__ void ln_rows(Frame& F, const float* src, float* dst, bf16* dstb, const float* g, const float* bb) {
    for (int t = F.gw; t < T; t += F.NGW) {
        float v[16]; float s = 0.f;
#pragma unroll
        for (int j = 0; j < 2; ++j) { const f32x4* p = (const f32x4*)(src + (size_t)t * DM + 8 * F.lane + 512 * j); const f32x4 a = p[0], b = p[1];
#pragma unroll
            for (int x = 0; x < 4; ++x) { v[j * 8 + x] = a[x]; v[j * 8 + 4 + x] = b[x]; } }
#pragma unroll
        for (int i = 0; i < 16; ++i) s += v[i];
        const float mean = wave_sum(s) * (1.f / DM); float s2 = 0.f;
#pragma unroll
        for (int i = 0; i < 16; ++i) { v[i] -= mean; s2 += v[i] * v[i]; }
        const float rstd = __builtin_amdgcn_rsqf(wave_sum(s2) * (1.f / DM) + LN_EPS);
#pragma unroll
        for (int j = 0; j < 2; ++j) { const int col = 8 * F.lane + 512 * j; const f32x4* gp = (const f32x4*)(g + col); const f32x4* bp = (const f32x4*)(bb + col);
            const f32x4 g0 = gp[0], g1 = gp[1], b0 = bp[0], b1 = bp[1]; f32x4 o0, o1;
#pragma unroll
            for (int x = 0; x < 4; ++x) { o0[x] = v[j * 8 + x] * rstd * g0[x] + b0[x]; o1[x] = v[j * 8 + 4 + x] * rstd * g1[x] + b1[x]; }
            f32x4* dp = (f32x4*)(dst + (size_t)t * DM + col); dp[0] = o0; dp[1] = o1;
            if (dstb) { v4u wv; wv.x = pk2(o0[0], o0[1]); wv.y = pk2(o0[2], o0[3]); wv.z = pk2(o1[0], o1[1]); wv.w = pk2(o1[2], o1[3]); *(v4u*)(dstb + (size_t)t * DM + col) = wv; } }
    }
}
__device__ __forceinline__ void combine_rows(Frame& F, const float* x1, const bf16* ys, const float* selg, float* dst, bf16* dstb, const float* g, const float* bb) {
    for (int t = F.gw; t < T; t += F.NGW) {
        float v[16];
#pragma unroll
        for (int j = 0; j < 2; ++j) { const f32x4* p = (const f32x4*)(x1 + (size_t)t * DM + 8 * F.lane + 512 * j); const f32x4 a = p[0], b = p[1];
#pragma unroll
            for (int x = 0; x < 4; ++x) { v[j * 8 + x] = a[x] * DN_ALPHA; v[j * 8 + 4 + x] = b[x] * DN_ALPHA; } }
#pragma unroll
        for (int k = 0; k < 9; ++k) { const float gk = k < 8 ? selg[(size_t)t * 8 + k] : 1.f; const size_t row = k < 8 ? (size_t)t * 8 + k : (size_t)T * 8 + t;
#pragma unroll
            for (int j = 0; j < 2; ++j) { const v4u wv = *(const v4u*)(ys + row * DM + 8 * F.lane + 512 * j);
                v[j * 8 + 0] += gk * bf_lo(wv.x); v[j * 8 + 1] += gk * bf_hi(wv.x); v[j * 8 + 2] += gk * bf_lo(wv.y); v[j * 8 + 3] += gk * bf_hi(wv.y);
                v[j * 8 + 4] += gk * bf_lo(wv.z); v[j * 8 + 5] += gk * bf_hi(wv.z); v[j * 8 + 6] += gk * bf_lo(wv.w); v[j * 8 + 7] += gk * bf_hi(wv.w); } }
        float s = 0.f;
#pragma unroll
        for (int i = 0; i < 16; ++i) s += v[i];
        const float mean = wave_sum(s) * (1.f / DM); float s2 = 0.f;
#pragma unroll
        for (int i = 0; i < 16; ++i) { v[i] -= mean; s2 += v[i] * v[i]; }
        const float rstd = __builtin_amdgcn_rsqf(wave_sum(s2) * (1.f / DM) + LN_EPS);
#pragma unroll
        for (int j = 0; j < 2; ++j) { const int col = 8 * F.lane + 512 * j; const f32x4* gp = (const f32x4*)(g + col); const f32x4* bp = (const f32x4*)(bb + col);
            const f32x4 g0 = gp[0], g1 = gp[1], b0 = bp[0], b1 = bp[1]; f32x4 o0, o1;
#pragma unroll
            for (int x = 0; x < 4; ++x) { o0[x] = v[j * 8 + x] * rstd * g0[x] + b0[x]; o1[x] = v[j * 8 + 4 + x] * rstd * g1[x] + b1[x]; }
            f32x4* dp = (f32x4*)(dst + (size_t)t * DM + col); dp[0] = o0; dp[1] = o1;
            if (dstb) { v4u wv; wv.x = pk2(o0[0], o0[1]); wv.y = pk2(o0[2], o0[3]); wv.z = pk2(o1[0], o1[1]); wv.w = pk2(o1[2], o1[3]); *(v4u*)(dstb + (size_t)t * DM + col) = wv; } }
    }
}
__device__ __forceinline__ float dpp_xor1(float v) { return __builtin_bit_cast(float, __builtin_amdgcn_update_dpp(0, __builtin_bit_cast(int, v), 0xB1, 0xF, 0xF, true)); }
__device__ __forceinline__ float dpp_xor2(float v) { return __builtin_bit_cast(float, __builtin_amdgcn_update_dpp(0, __builtin_bit_cast(int, v), 0x4E, 0xF, 0xF, true)); }
__device__ __forceinline__ float dpp_hmir(float v) { return __builtin_bit_cast(float, __builtin_amdgcn_update_dpp(0, __builtin_bit_cast(int, v), 0x141, 0xF, 0xF, true)); }
__device__ __forceinline__ unsigned fkey(float f) { const unsigned u = __builtin_bit_cast(unsigned, f); return u ^ ((u >> 31) ? 0xFFFFFFFFu : 0x80000000u); }
__device__ __forceinline__ void route_rows(Frame& F, const float* logits, const float* rbias, unsigned* bcnt, int* sel_e, float* sel_g, int* sel_pos) {
    const int lane = F.lane;
    LAS int* lcnt = (LAS int*)(F.lds + L_LCNT);
    if (F.tid < 256) lcnt[F.tid] = 0;
    __syncthreads();
    const f32x4 bv = *(const f32x4*)(rbias + 4 * lane);
    for (int t = F.gw; t < T; t += F.NGW) {
        const f32x4 lg = *(const f32x4*)(logits + (size_t)t * NEXP + 4 * lane);
        float s[4], c[4];
#pragma unroll
        for (int j = 0; j < 4; ++j) { s[j] = __builtin_amdgcn_rcpf(1.f + __builtin_amdgcn_exp2f(-lg[j] * LOG2E)); c[j] = s[j] + bv[j]; }
        float m1 = fmaxf(c[0], c[1]), m2 = fminf(c[0], c[1]);
        { const float a = fmaxf(c[2], c[3]), b2 = fminf(c[2], c[3]); const float n1 = fmaxf(m1, a); m2 = fmaxf(fminf(m1, a), fmaxf(m2, b2)); m1 = n1; }
        { float o1 = dpp_xor1(m1), o2 = dpp_xor1(m2); float n1 = fmaxf(m1, o1); m2 = fmaxf(fminf(m1, o1), fmaxf(m2, o2)); m1 = n1;
          o1 = dpp_xor2(m1); o2 = dpp_xor2(m2); n1 = fmaxf(m1, o1); m2 = fmaxf(fminf(m1, o1), fmaxf(m2, o2)); m1 = n1;
          o1 = dpp_hmir(m1); o2 = dpp_hmir(m2); n1 = fmaxf(m1, o1); m2 = fmaxf(fminf(m1, o1), fmaxf(m2, o2)); m1 = n1; }
        const float gs = m1 + m2; const int mygrp = lane >> 3; int rank = 0;
#pragma unroll
        for (int j = 0; j < 8; ++j) { const float gj = __builtin_bit_cast(float, __builtin_amdgcn_readlane(__builtin_bit_cast(int, gs), j * 8)); rank += (gj > gs || (gj == gs && j < mygrp)) ? 1 : 0; }
        const bool gsel = rank < 4;
        unsigned key[4];
#pragma unroll
        for (int j = 0; j < 4; ++j) key[j] = gsel ? fkey(c[j]) : 0u;
        unsigned lo = 0u, hi = 0xFFFFFFFFu, tau = 0u; bool exact8 = false;
#define CNT_GE(x) (__builtin_popcountll(__ballot(key[0] >= (x))) + __builtin_popcountll(__ballot(key[1] >= (x))) + __builtin_popcountll(__ballot(key[2] >= (x))) + __builtin_popcountll(__ballot(key[3] >= (x))))
        { const unsigned p0 = 0xBF000000u  ; const int c0 = CNT_GE(p0); if (c0 >= TOPK) lo = p0; else hi = p0;
          const unsigned p1 = (c0 >= TOPK) ? 0xBFC00000u   : 0xBE000000u  ; const int c1 = CNT_GE(p1); if (c1 >= TOPK) lo = p1; else hi = p1;
          if (c0 == TOPK) { tau = p0; exact8 = true; } if (c1 == TOPK) { tau = p1; exact8 = true; } }
#pragma unroll 1
        while (!exact8 && hi - lo > 1u) { const unsigned mid = lo + ((hi - lo) >> 1); const int cnt = CNT_GE(mid);
            if (cnt == TOPK) { tau = mid; exact8 = true; } else if (cnt > TOPK) lo = mid; else hi = mid; }
#undef CNT_GE
        if (!exact8) tau = lo;
        if (exact8) tau -= 1u;
        unsigned long long bg[4], be[4]; int ngt = 0;
#pragma unroll
        for (int j = 0; j < 4; ++j) { bg[j] = __ballot(key[j] > tau); be[j] = __ballot(key[j] == tau); ngt += __builtin_popcountll(bg[j]); }
        int need = TOPK - ngt;
        bool sel[4]; int slot[4]; int base = 0;
        const unsigned long long lt = (1ull << lane) - 1ull;
#pragma unroll
        for (int j = 0; j < 4; ++j) { sel[j] = (bg[j] >> lane) & 1ull; slot[j] = base + __builtin_popcountll(bg[j] & lt); base += __builtin_popcountll(bg[j]); }
        {
          int eqrank = 0;
#pragma unroll
          for (int j = 0; j < 4; ++j) eqrank += __builtin_popcountll(be[j] & lt);
#pragma unroll
          for (int j = 0; j < 4; ++j) { const bool iseq = (be[j] >> lane) & 1ull; if (iseq && eqrank < need) { sel[j] = true; slot[j] = ngt + eqrank; } eqrank += iseq ? 1 : 0; } }
        LAS float* gsc = (LAS float*)(F.lds + RING_OFF) + F.wave * 8;
#pragma unroll
        for (int j = 0; j < 4; ++j) if (sel[j]) gsc[slot[j]] = s[j];
        LDS_WAIT();
        float ssum = 0.f;
#pragma unroll
        for (int q = 0; q < 8; ++q) ssum += gsc[q];
        LDS_WAIT();
        const float rs = 2.5f / ssum;
#pragma unroll
        for (int j = 0; j < 4; ++j) if (sel[j]) { const int e = 4 * lane + j;
            const int pos = __hip_atomic_fetch_add(lcnt + e, 1, __ATOMIC_RELAXED, __HIP_MEMORY_SCOPE_WORKGROUP);
            sel_e[(size_t)t * 8 + slot[j]] = e; sel_g[(size_t)t * 8 + slot[j]] = s[j] * rs; sel_pos[(size_t)t * 8 + slot[j]] = pos; }
    }
    __syncthreads();
    if (F.tid < 256) bcnt[(size_t)F.vcu * 256 + F.tid] = (unsigned)lcnt[F.tid];
}

#ifndef ATT_SEL
#define ATT_SEL 7
#endif
__device__ __forceinline__ void make_frame(Frame& F, unsigned char* lds_raw) {
    const CAS Args* ka = launder_ka((const CAS Args*)__builtin_amdgcn_kernarg_segment_ptr());
    F.lds = (LAS unsigned char*)lds_raw; F.ldsg = (char*)lds_raw;
    F.tid = launder_v((int)threadIdx.x); F.lane = F.tid & 63; F.wave = __builtin_amdgcn_readfirstlane(F.tid >> 6);
    F.G = gridDim.x; { const int bx = blockIdx.x; F.vcu = (F.G % 8 == 0) ? (bx % 8) * (F.G / 8) + bx / 8 : bx; }
    F.gw = F.vcu * NWAVES + F.wave; F.NGW = F.G * NWAVES; F.gt = F.vcu * (NWAVES * 64) + F.tid; F.NGT = F.G * NWAVES * 64;
    F.ws = ka->ws; F.ctl = (unsigned*)(ka->ws + WS_CTL);
}
#define WSP(type, off) ((type*)(F.ws + (off)))
__global__ void __launch_bounds__(NWAVES * 64, 2) mk_fwd(Args args) {
    extern __shared__ __attribute__((aligned(16))) unsigned char lds_raw[];
    volatile LAS unsigned* MISC = (volatile LAS unsigned*)((LAS unsigned char*)lds_raw + LDSCTL_OFF);
    for (int u = threadIdx.x; u < 128; u += NWAVES * 64) MISC[u] = 0u;
    __syncthreads();
    XcdBarrier bar; bar.bar = (unsigned*)(args.ws + WS_CTL) + CW_BAR; bar.x = 0; bar.st = nullptr;
    if (MK_N_LAUNCHES == 1) bar = xcd_barrier_post((unsigned*)(args.ws + WS_CTL) + CW_BAR, MISC + 8);
    const int lo = args.ph_lo, hi = args.ph_hi;
#ifndef PH_MASK
#define PH_MASK 0x7ff
#endif
#define IN(k) (((PH_MASK >> ((k) % 11)) & 1) && lo <= (k) && (k) < hi)
#ifndef PH_REPEAT
#define PH_REPEAT 0u
#endif
#define REPS(k) (1 + (int)((PH_REPEAT >> (k)) & 1u))
#define SEAM(k) do { if (IN(k) && IN((k) + 1)) xcd_barrier(bar); } while (0)

    for (int rep_ = 0; rep_ < REPS(0); ++rep_) if (IN(0)) {
        Frame F; make_frame(F, lds_raw);
        const CAS Args* ka = launder_ka((const CAS Args*)__builtin_amdgcn_kernarg_segment_ptr());
        const float* const CAS* in = ka->in;
        LAS float* scr = (LAS float*)(F.lds + RING_OFF + F.wave * 16384);
        constexpr int I_IN0 = 16 * 96, I_OUT = 16 * 32, I_R = 16 * 8, I_IN1 = 16 * 48;
        constexpr int NIT = I_IN0 + I_OUT + I_R + I_IN1 + I_OUT + I_R;
        for (int it = F.gw; it < NIT; it += F.NGW) {
            int r = it;
            if (r < I_IN0) { conv_dense_item(in[1], 1024, 3072, WSP(bf16, WS_W0IN), r, 1536, 2560, scr, F.lane); continue; } r -= I_IN0;
            if (r < I_OUT) { conv_dense_item(in[2], 1024, 1024, WSP(bf16, WS_W0OUT), r, 0, 0, scr, F.lane); continue; } r -= I_OUT;
            if (r < I_R)   { conv_dense_item(in[11], 1024, 256, WSP(bf16, WS_R0), r, 0, 0, scr, F.lane); continue; } r -= I_R;
            if (r < I_IN1) { conv_dense_item(in[21], 1024, 1536, WSP(bf16, WS_W1IN), r, 0, 1280, scr, F.lane); continue; } r -= I_IN1;
            if (r < I_OUT) { conv_dense_item(in[22], 1024, 1024, WSP(bf16, WS_W1OUT), r, 0, 0, scr, F.lane); continue; } r -= I_OUT;
            conv_dense_item(in[26], 1024, 256, WSP(bf16, WS_R1), r, 0, 0, scr, F.lane);
        }
        { const float* x = in[0]; bf16* XB = WSP(bf16, WS_XB);
          for (size_t i = (size_t)F.gt; i < (size_t)T * DM / 8; i += (size_t)F.NGT) { const f32x4* p = (const f32x4*)(x + i * 8); const f32x4 a = p[0], b = p[1];
              v4u wv; wv.x = pk2(a[0], a[1]); wv.y = pk2(a[2], a[3]); wv.z = pk2(b[0], b[1]); wv.w = pk2(b[2], b[3]); *(v4u*)(XB + i * 8) = wv; } }
        { float* ROPE = WSP(float, WS_ROPE);
          for (int i = F.gt; i < SEQ * 32; i += F.NGT) { const int pos = i >> 5, fi = i & 31;
            const float inv = 1.0f / __powf(10000.f, (float)(2 * fi) * (1.f / 64.f));
            const float ang = (float)pos * inv;
            const double tt = (double)ang * 0.15915494309189535; const float fr = (float)(tt - floor(tt));
            ROPE[2 * i] = __builtin_amdgcn_cosf(fr); ROPE[2 * i + 1] = __builtin_amdgcn_sinf(fr); } }
    }
    SEAM(0);
#pragma unroll 1
    for (int layer = 0; layer < 2; ++layer) {
        const int pb = layer * 11;
        for (int rep_ = 0; rep_ < REPS(pb + 1); ++rep_) if (IN(pb + 1)) {
            Frame F; make_frame(F, lds_raw);
            pg8::DenseOrder S;
            EpiProj E; E.O = WSP(bf16, WS_HCAT); E.rope = WSP(float, WS_ROPE);
            if (layer == 0) { S.init(WSP(bf16, WS_XB), F.ws + WS_W0IN, T, 3072, 1024, F.G, (int)blockIdx.x); E.ldc = 3072; E.ropemask = 0x3C0u; E.scalemask = 0x0C3u; }
            else            { S.init(WSP(bf16, WS_X1B), F.ws + WS_W1IN, T, 1536, 1024, F.G, (int)blockIdx.x); E.ldc = 1536; E.ropemask = 0x01Fu; E.scalemask = 0x00Fu; }
            pg8::gemm_phase<EpiProj, pg8::DenseOrder, true>(F.lds + RING_OFF, 1024, S, E);
        }
        SEAM(pb + 1);
        for (int rep_ = 0; rep_ < REPS(pb + 2); ++rep_) if (IN(pb + 2)) {
            Frame F; make_frame(F, lds_raw);
            const CAS Args* ka = launder_ka((const CAS Args*)__builtin_amdgcn_kernarg_segment_ptr());
            const float* const CAS* in = ka->in;
            if (layer == 0) {
                float lam;
                { const float* lq1 = in[4]; const float* lk1 = in[5]; const float* lq2 = in[6]; const float* lk2 = in[7];
                  const float a = wave_sum(lq1[F.lane] * lk1[F.lane]), b2 = wave_sum(lq2[F.lane] * lk2[F.lane]); lam = __expf(a) - __expf(b2) + LAMBDA_INIT0; }
                if (ATT_SEL & 1) for (int u = F.vcu; u < 512; u += F.G) diff_unit(F, u >> 7, (u >> 5) & 3, u & 31, WSP(bf16, WS_HCAT), WSP(bf16, WS_ATT), lam, in[8], WSP(float, WS_O1S));
                if (ATT_SEL & 2) for (int u = F.vcu; u < 1024; u += F.G) na_unit(F, u >> 8, (u >> 5) & 7, u & 31, WSP(bf16, WS_HCAT), WSP(bf16, WS_ATT), in[3]);
                __syncthreads();
                conv_egu(F, in[13], in[14], in[16], in[17], WSP(bf16, WS_EGU));
                conv_ed(F, in[15], in[18], WSP(bf16, WS_ED));
                conv_egu(F, in[28], in[29], in[31], in[32], WSP(bf16, WS_EGU1));
            } else {
                if (ATT_SEL & 4) for (int u = F.vcu; u < 2048; u += F.G) swa_unit(F, u >> 9, (u >> 5) & 15, u & 31, WSP(bf16, WS_HCAT), WSP(bf16, WS_ATT), in[23]);
            }
        }
        SEAM(pb + 2);
        for (int rep_ = 0; rep_ < REPS(pb + 3); ++rep_) if (IN(pb + 3)) {
            Frame F; make_frame(F, lds_raw);
            const CAS Args* ka = launder_ka((const CAS Args*)__builtin_amdgcn_kernarg_segment_ptr());
            pg8::DenseOrder S; S.init(WSP(bf16, WS_ATT), F.ws + (layer == 0 ? WS_W0OUT : WS_W1OUT), T, 1024, 1024, F.G, (int)blockIdx.x);
            EpiRes E; E.C = WSP(float, WS_Y); E.ldc = 1024; E.res = layer == 0 ? ka->in[0] : WSP(float, WS_X1); E.alpha = DN_ALPHA;
            pg8::gemm_phase<EpiRes, pg8::DenseOrder, true>(F.lds + RING_OFF, 1024, S, E);
        }
        SEAM(pb + 3);
        for (int rep_ = 0; rep_ < REPS(pb + 4); ++rep_) if (IN(pb + 4)) {
            Frame F; make_frame(F, lds_raw);
            const CAS Args* ka = launder_ka((const CAS Args*)__builtin_amdgcn_kernarg_segment_ptr());
            ln_rows(F, WSP(float, WS_Y), WSP(float, WS_X1), WSP(bf16, WS_X1B), ka->in[layer == 0 ? 9 : 24], ka->in[layer == 0 ? 10 : 25]);
        }
        SEAM(pb + 4);
        for (int rep_ = 0; rep_ < REPS(pb + 5); ++rep_) if (IN(pb + 5)) {
            Frame F; make_frame(F, lds_raw);
            pg8::DenseOrder S; S.init(WSP(bf16, WS_X1B), F.ws + (layer == 0 ? WS_R0 : WS_R1), T, 256, 1024, F.G, (int)blockIdx.x);
            EpiRes E; E.C = WSP(float, WS_H); E.ldc = 256; E.res = nullptr; E.alpha = 0.f;
            pg8::gemm_phase<EpiRes, pg8::DenseOrder, true>(F.lds + RING_OFF, 1024, S, E);
        }
        SEAM(pb + 5);
        for (int rep_ = 0; rep_ < REPS(pb + 6); ++rep_) if (IN(pb + 6)) {
            Frame F; make_frame(F, lds_raw);
            const CAS Args* ka = launder_ka((const CAS Args*)__builtin_amdgcn_kernarg_segment_ptr());
            route_rows(F, WSP(float, WS_H), ka->in[layer == 0 ? 12 : 27], WSP(unsigned, WS_BCNT), WSP(int, WS_SEL_E), WSP(float, WS_SEL_G), WSP(int, WS_SEL_POS));
        }
        SEAM(pb + 6);
        for (int rep_ = 0; rep_ < REPS(pb + 7); ++rep_) if (IN(pb + 7)) {
            Frame F; make_frame(F, lds_raw);
            unsigned* counts = F.ctl + CW_CNT + 256 * layer;
            int* SEL_E = WSP(int, WS_SEL_E); int* SEL_POS = WSP(int, WS_SEL_POS); int* GTOK = WSP(int, WS_GTOK); int* DEST = WSP(int, WS_DEST);
            LAS int* pre = (LAS int*)(F.lds + L_LCNT);
            int tot = 0;
            if (F.tid < 256) { const unsigned* bc = WSP(unsigned, WS_BCNT) + F.tid; int pr = 0;
                for (int b = 0; b < F.G; ++b) { const int v = (int)bc[(size_t)b * 256]; tot += v; pr += (b < F.vcu) ? v : 0; }
                pre[F.tid] = pr; if (F.vcu == 0) counts[F.tid] = (unsigned)tot; }
            build_tiles_cnt(F, tot);
            const LAS int* ps = (const LAS int*)(F.lds + L_PADSTART);
            for (int t0 = F.gw; t0 < T; t0 += 8 * F.NGW) {
                const int t = t0 + (F.lane >> 3) * F.NGW;
                if (t < T) { const int a = t * 8 + (F.lane & 7); const int e = SEL_E[a]; const int slot = ps[e] + pre[e] + SEL_POS[a]; GTOK[slot] = t; DEST[slot] = a; } }
            for (int e = F.vcu; e < NEXP; e += F.G) { const unsigned* bc = WSP(unsigned, WS_BCNT) + e; int c = 0; for (int b = F.lane; b < F.G; b += 64) c += (int)bc[(size_t)b * 256]; c = (int)wave_sum((float)c);
                const int st = ps[e] + c, en = ps[e + 1]; for (int s = st + F.tid; s < en; s += NWAVES * 64) { GTOK[s] = 0; DEST[s] = -1; } }
            for (int t = F.gt; t < T; t += F.NGT) { GTOK[NSLOT_MAX + t] = t; DEST[NSLOT_MAX + t] = T * 8 + t; }
        }
        SEAM(pb + 7);
        for (int rep_ = 0; rep_ < REPS(pb + 8); ++rep_) if (IN(pb + 8)) {
            Frame F; make_frame(F, lds_raw);
            build_tiles(F, F.ctl + CW_CNT + 256 * layer);
            MoeOrder<true, 1> S; S.R = ((const LAS int*)(F.lds + L_PADSTART))[256] >> 8; S.G = F.G; S.c = F.vcu; S.K = 1024; S.te = (const LAS unsigned short*)(F.lds + L_TILE_E); S.gtok = WSP(int, WS_GTOK);
            S.A = (const char*)WSP(bf16, WS_X1B); S.B = (const char*)(F.ws + (layer == 0 ? WS_EGU : WS_EGU1)); S.bexp = (size_t)512 * 1024 * 2; S.btile = (size_t)256 * 1024 * 2;
            EpiSwiGLU E; E.H = WSP(bf16, WS_H);
            pg8::gemm_phase<EpiSwiGLU, MoeOrder<true, 1>, true>(F.lds + RING_OFF, 1024, S, E);
        }
        SEAM(pb + 8);
        for (int rep_ = 0; rep_ < REPS(pb + 9); ++rep_) if (IN(pb + 9)) {
            Frame F; make_frame(F, lds_raw);
            build_tiles(F, F.ctl + CW_CNT + 256 * layer);
            MoeOrder<false, 2> S; S.R = ((const LAS int*)(F.lds + L_PADSTART))[256] >> 8; S.G = F.G; S.c = F.vcu; S.K = 256; S.te = (const LAS unsigned short*)(F.lds + L_TILE_E); S.gtok = nullptr;
            S.A = (const char*)WSP(bf16, WS_H); S.B = (const char*)WSP(bf16, WS_ED); S.bexp = (size_t)1024 * 256 * 2; S.btile = (size_t)256 * 256 * 2;
            EpiDown E; E.YS = WSP(bf16, WS_YS); E.dest = WSP(int, WS_DEST);
            pg8::gemm_phase<EpiDown, MoeOrder<false, 2>, true>(F.lds + RING_OFF, 256, S, E);
        }
        SEAM(pb + 9);
        for (int rep_ = 0; rep_ < REPS(pb + 10); ++rep_) if (IN(pb + 10)) {
            Frame F; make_frame(F, lds_raw);
            const CAS Args* ka = launder_ka((const CAS Args*)__builtin_amdgcn_kernarg_segment_ptr());
            const float* const CAS* in = ka->in;
            if (layer == 0) { combine_rows(F, WSP(float, WS_X1), WSP(bf16, WS_YS), WSP(float, WS_SEL_G), WSP(float, WS_X1), WSP(bf16, WS_X1B), in[19], in[20]);
                              conv_ed(F, in[30], in[33], WSP(bf16, WS_ED)); }
            else combine_rows(F, WSP(float, WS_X1), WSP(bf16, WS_YS), WSP(float, WS_SEL_G), ka->out, nullptr, in[34], in[35]);
        }
        if (layer == 0) { SEAM(pb + 10); }
    }
#undef IN
#undef SEAM
}

extern "C" void kernel_launch(void* const* d_in, const int* in_sizes, int n_in, void* d_out, int out_size, void* d_ws, size_t ws_size, hipStream_t stream) {
    static int grid = 0;
    if (grid == 0) {
        if (n_in != 36 || in_sizes[0] != T * DM || out_size != T * DM || ws_size < WS_END) { fprintf(stderr, "kernel_launch: shape/workspace mismatch (n_in %d, ws %zu, need %zu)\n", n_in, ws_size, (size_t)WS_END); grid = -1; return; }
        int dev = 0, cus = 0, per_cu = 0;
        if (hipGetDevice(&dev) != hipSuccess || hipDeviceGetAttribute(&cus, hipDeviceAttributeMultiprocessorCount, dev) != hipSuccess) { grid = -1; return; }
        if (hipFuncSetAttribute((const void*)mk_fwd, hipFuncAttributeMaxDynamicSharedMemorySize, LDS_BYTES) != hipSuccess) { fprintf(stderr, "kernel_launch: hipFuncSetAttribute failed\n"); grid = -1; return; }
        if (hipOccupancyMaxActiveBlocksPerMultiprocessor(&per_cu, (const void*)mk_fwd, NWAVES * 64, LDS_BYTES) != hipSuccess || per_cu < 1) { fprintf(stderr, "kernel_launch: occupancy query says %d\n", per_cu); }
        (void)hipGetLastError();
        grid = cus;
    }
    if (grid < 0) return;
    if (hipMemsetAsync((char*)d_ws + WS_CTL, 0, CTL_ZERO_BYTES, stream) != hipSuccess) return;
    Args a{};
    for (int i = 0; i < 36; ++i) a.in[i] = (const float*)d_in[i];
    a.out = (float*)d_out; a.ws = (unsigned char*)d_ws;
    if (MK_N_LAUNCHES == 1) { a.ph_lo = 0; a.ph_hi = NPH; hipLaunchKernelGGL(mk_fwd, dim3(grid), dim3(NWAVES * 64), LDS_BYTES, stream, a); }
    else { for (int p = 0; p < NPH; ++p) { if (p == 11) continue; a.ph_lo = p; a.ph_hi = p + 1; hipLaunchKernelGGL(mk_fwd, dim3(grid), dim3(NWAVES * 64), LDS_BYTES, stream, a); } }
}
```
